# Optimizing an MI355X kernel written in HIP

```python
import math
import jax
import jax.numpy as jnp
from jax import lax
import numpy as np

D_MODEL = 1024
BATCH = 8
SEQ = 2048
DEPTH = 4

MEM_LEN = 256
NORM_EPS = 1e-6
DOC_MEAN_LEN = 512
MASK_VALUE = -1e30
GATE_FLOOR = 1e-30

N_BRANCH = 4
BRANCH_W = D_MODEL // 4

MLA_HEADS = 4
MLA_Q_RANK = D_MODEL // 4
MLA_KV_RANK = D_MODEL // 8
MLA_NOPE = 64
MLA_ROPE = 32
MLA_V = BRANCH_W // MLA_HEADS
ROPE_THETA = 10000.0
Q_BLOCK = 128

HG_HEADS = 4
HG_DIM = BRANCH_W // HG_HEADS
HG_CHUNK = 16

ML_HEADS = 4
ML_DIM = BRANCH_W // ML_HEADS
ML_CONV = 4
ML_CHUNK = 64

S5_GROUP_CH = 16
S5_GROUPS = BRANCH_W // S5_GROUP_CH
S5_STATE = 64
S5_DT_MIN = 0.001
S5_DT_MAX = 0.1

XA_HEADS = 4
XA_DIM = D_MODEL // XA_HEADS

D_FF = ((8 * D_MODEL + 3 * 256 - 1) // (3 * 256)) * 256

SPLIT_SIZES = (MLA_Q_RANK, MLA_KV_RANK, MLA_ROPE,
               BRANCH_W, BRANCH_W, BRANCH_W, BRANCH_W,
               BRANCH_W, BRANCH_W, BRANCH_W, ML_HEADS, ML_HEADS,
               BRANCH_W,
               N_BRANCH * D_MODEL)
N_IN = sum(SPLIT_SIZES)

kernel_name = 'hybrid_mla_hgrn2_mlstm_s5_block'


def rms_norm(x, gain):
    xf = x.astype(jnp.float32)
    y = xf * lax.rsqrt(jnp.mean(xf * xf, axis=-1, keepdims=True) + NORM_EPS)
    return (y * gain.astype(jnp.float32)).astype(x.dtype)


def apply_rope(x, positions):
    half = x.shape[-1] // 2
    inv_freq = ROPE_THETA ** (-jnp.arange(half, dtype=jnp.float32) / half)
    ang = positions.astype(jnp.float32)[:, :, None, None] * inv_freq
    cos, sin = jnp.cos(ang), jnp.sin(ang)
    xf = x.astype(jnp.float32)
    x1, x2 = xf[..., :half], xf[..., half:]
    return jnp.concatenate([x1 * cos - x2 * sin, x2 * cos + x1 * sin], axis=-1).astype(x.dtype)


def causal_block_attention(q, k, v, scale):
    B, T, H, _ = q.shape
    nb = T // Q_BLOCK
    qb = q.reshape(B, nb, Q_BLOCK, H, -1).swapaxes(0, 1)
    kpos = jnp.arange(T)

    def one_block(args):
        qi, bi = args
        s = jnp.einsum('bqhd,bkhd->bhqk', qi, k).astype(jnp.float32) * scale
        qpos = bi * Q_BLOCK + jnp.arange(Q_BLOCK)
        s = jnp.where(kpos[None, :] <= qpos[:, None], s, MASK_VALUE)
        p = jax.nn.softmax(s, axis=-1).astype(v.dtype)
        return jnp.einsum('bhqk,bkhd->bqhd', p, v)

    out = lax.map(one_block, (qb, jnp.arange(nb)))
    return out.swapaxes(0, 1).reshape(B, T, H, -1)


def hgrn2_chunked(q, k, v, log_f):
    B, T, H, Dk = q.shape
    Dv = v.shape[-1]
    L = HG_CHUNK
    nc = T // L
    q, k, v, log_f = (a.reshape(B, nc, L, H, a.shape[-1]) for a in (q, k, v, log_f))
    b = jnp.cumsum(log_f, axis=2)
    b_end = b[:, :, -1]
    causal = jnp.tril(jnp.ones((L, L), dtype=bool))
    diff = b[:, :, :, None] - b[:, :, None]
    decay = jnp.exp(jnp.where(causal[None, None, :, :, None, None], diff, MASK_VALUE))
    scores = jnp.einsum('bcthd,bctshd,bcshd->bchts', q, decay, k)
    o_intra = jnp.einsum('bchts,bcshe->bcthe', scores, v)
    kv_end = jnp.einsum('bcshd,bcshe->bchde', k * jnp.exp(b_end[:, :, None] - b), v)

    def step(S, xs):
        dec, kv = xs
        return jnp.exp(dec)[..., None] * S + kv, S

    _, S0 = lax.scan(step, jnp.zeros((B, H, Dk, Dv), jnp.float32),
                     (b_end.swapaxes(0, 1), kv_end.swapaxes(0, 1)))
    S0 = S0.swapaxes(0, 1)
    o_inter = jnp.einsum('bcthd,bchde->bcthe', q * jnp.exp(b), S0)
    return (o_intra + o_inter).reshape(B, T, H, Dv)


def mlstm_chunked(q, k, v, i_log, f_log):
    B, T, H, Dk = q.shape
    Dv = v.shape[-1]
    L = ML_CHUNK
    nc = T // L
    q, k, v = (a.reshape(B, nc, L, H, a.shape[-1]) for a in (q, k, v))
    i_log = i_log.reshape(B, nc, L, H)
    b = jnp.cumsum(f_log.reshape(B, nc, L, H), axis=2)
    b_end = b[:, :, -1]
    g_end = b_end[:, :, None] - b + i_log

    def step(carry, xs):
        C, n, m = carry
        be, ge, kc, vc = xs
        m_new = jnp.maximum(be + m, ge.max(axis=1))
        keep = jnp.exp(be + m - m_new)
        w = jnp.exp(ge - m_new[:, None])
        C_new = keep[..., None, None] * C + jnp.einsum('blh,blhd,blhe->bhde', w, kc, vc)
        n_new = keep[..., None] * n + jnp.einsum('blh,blhd->bhd', w, kc)
        return (C_new, n_new, m_new), (C, n, m)

    init = (jnp.zeros((B, H, Dk, Dv), jnp.float32), jnp.zeros((B, H, Dk), jnp.float32),
            jnp.zeros((B, H), jnp.float32))
    _, (C0, n0, m0) = lax.scan(step, init, (b_end.swapaxes(0, 1), g_end.swapaxes(0, 1),
                                            k.swapaxes(0, 1), v.swapaxes(0, 1)))
    C0, n0, m0 = C0.swapaxes(0, 1), n0.swapaxes(0, 1), m0.swapaxes(0, 1)
    causal = jnp.tril(jnp.ones((L, L), dtype=bool))
    dmat = b[:, :, :, None, :] - b[:, :, None, :, :] + i_log[:, :, None, :, :]
    dmat = jnp.where(causal[None, None, :, :, None], dmat, MASK_VALUE)
    a = b + m0[:, :, None, :]
    m_t = jnp.maximum(a, dmat.max(axis=3))
    w_intra = jnp.exp(dmat - m_t[:, :, :, None, :])
    w_inter = jnp.exp(a - m_t)
    qk = jnp.einsum('bcthd,bcshd->bctsh', q, k) * w_intra
    num = (jnp.einsum('bctsh,bcshe->bcthe', qk, v)
           + w_inter[..., None] * jnp.einsum('bcthd,bchde->bcthe', q, C0))
    den = qk.sum(axis=3) + w_inter * jnp.einsum('bcthd,bchd->bcth', q, n0)
    h = num / jnp.maximum(jnp.abs(den), jnp.exp(-m_t))[..., None]
    return h.reshape(B, T, H, Dv)


def causal_depthwise_conv(x, w, b):
    y = lax.conv_general_dilated(x, w.astype(x.dtype)[:, None, :], window_strides=(1,),
                                 padding=((ML_CONV - 1, 0),),
                                 dimension_numbers=('NWC', 'WIO', 'NWC'),
                                 feature_group_count=x.shape[-1])
    return y + b.astype(x.dtype)


def _complex_linear_combine(e1, e2):
    ar1, ai1, br1, bi1 = e1
    ar2, ai2, br2, bi2 = e2
    return (ar2 * ar1 - ai2 * ai1, ar2 * ai1 + ai2 * ar1,
            ar2 * br1 - ai2 * bi1 + br2, ar2 * bi1 + ai2 * br1 + bi2)


def s5_ssm(u, a_re, a_im, log_dt, b_re, b_im, c_re, c_im, d):
    f32 = jnp.float32
    a_re, a_im = a_re.astype(f32), a_im.astype(f32)
    b_re, b_im, c_re, c_im = b_re.astype(f32), b_im.astype(f32), c_re.astype(f32), c_im.astype(f32)
    dt = jnp.exp(log_dt.astype(f32))[:, None]
    mag = jnp.exp(a_re * dt)
    ab_re, ab_im = mag * jnp.cos(a_im * dt), mag * jnp.sin(a_im * dt)
    inv_abs2 = 1.0 / (a_re * a_re + a_im * a_im)
    z_re = ((ab_re - 1.0) * a_re + ab_im * a_im) * inv_abs2
    z_im = (ab_im * a_re - (ab_re - 1.0) * a_im) * inv_abs2
    bb_re = z_re[..., None] * b_re - z_im[..., None] * b_im
    bb_im = z_re[..., None] * b_im + z_im[..., None] * b_re
    x_re = jnp.einsum('gph,btgh->btgp', bb_re, u)
    x_im = jnp.einsum('gph,btgh->btgp', bb_im, u)
    _, _, s_re, s_im = lax.associative_scan(
        _complex_linear_combine,
        (jnp.broadcast_to(ab_re, x_re.shape), jnp.broadcast_to(ab_im, x_im.shape), x_re, x_im),
        axis=1)
    return (jnp.einsum('ghp,btgp->btgh', c_re, s_re) - jnp.einsum('ghp,btgp->btgh', c_im, s_im)
            + d.astype(f32) * u)


def hybrid_token_mixer(h, positions, lower_bound, w_in, mla_q_norm, mla_w_uq, mla_kv_norm, mla_w_ukv,
                       hg_out_norm, ml_conv_w, ml_conv_b, ml_w_q, ml_w_k, ml_i_bias, ml_f_bias,
                       ml_out_norm, s5_a_re, s5_a_im, s5_log_dt, s5_b_re, s5_b_im, s5_c_re, s5_c_im,
                       s5_d, s5_w_glu, s5_b_glu, w_branch, w_out):
    B, T, _ = h.shape
    f32 = jnp.float32
    split_points = np.cumsum(SPLIT_SIZES)[:-1].tolist()
    (a_q, a_kv, a_kr, b_q, b_f, b_i, b_g, c_x, c_v, c_o, c_ig, c_fg, d_u,
     gate_logits) = jnp.split(h @ w_in, split_points, axis=-1)
    heads = lambda a, n: a.reshape(B, T, n, -1)

    q = (rms_norm(a_q, mla_q_norm) @ mla_w_uq).reshape(B, T, MLA_HEADS, MLA_NOPE + MLA_ROPE)
    q = jnp.concatenate([q[..., :MLA_NOPE], apply_rope(q[..., MLA_NOPE:], positions)], axis=-1)
    kv = (rms_norm(a_kv, mla_kv_norm) @ mla_w_ukv).reshape(B, T, MLA_HEADS, MLA_NOPE + MLA_V)
    k_rope = apply_rope(a_kr[:, :, None, :], positions)
    k = jnp.concatenate([kv[..., :MLA_NOPE],
                         jnp.broadcast_to(k_rope, (B, T, MLA_HEADS, MLA_ROPE))], axis=-1)
    out_a = causal_block_attention(q, k, kv[..., MLA_NOPE:],
                                   (MLA_NOPE + MLA_ROPE) ** -0.5).reshape(B, T, BRANCH_W)

    f_logit = b_f.astype(f32)
    lb = lower_bound.astype(f32)
    forget = lb + (1.0 - lb) * jax.nn.sigmoid(f_logit)
    log_f = jnp.log(jnp.maximum(forget, GATE_FLOOR))
    k_hg = (1.0 - lb) * jax.nn.sigmoid(-f_logit)
    o_hg = hgrn2_chunked(heads(jax.nn.silu(b_q.astype(f32)), HG_HEADS), heads(k_hg, HG_HEADS),
                         heads(b_i.astype(f32), HG_HEADS), heads(log_f, HG_HEADS))
    out_b = (rms_norm(o_hg, hg_out_norm.reshape(HG_HEADS, HG_DIM)).reshape(B, T, BRANCH_W)
             * jax.nn.silu(b_g.astype(f32)))

    xc = jax.nn.silu(causal_depthwise_conv(c_x, ml_conv_w, ml_conv_b)).reshape(B, T, ML_HEADS, ML_DIM)
    q_ml = jnp.einsum('bthd,hde->bthe', xc, ml_w_q).astype(f32)
    k_ml = jnp.einsum('bthd,hde->bthe', xc, ml_w_k).astype(f32) * ML_DIM ** -0.5
    i_log = c_ig.astype(f32) + ml_i_bias.astype(f32)
    f_log = jax.nn.log_sigmoid(c_fg.astype(f32) + ml_f_bias.astype(f32))
    h_ml = mlstm_chunked(q_ml, k_ml, heads(c_v.astype(f32), ML_HEADS), i_log, f_log)
    out_c = (jax.nn.sigmoid(c_o.astype(f32))
             * rms_norm(h_ml, ml_out_norm.reshape(ML_HEADS, ML_DIM)).reshape(B, T, BRANCH_W))

    u = d_u.astype(f32).reshape(B, T, S5_GROUPS, S5_GROUP_CH)
    y = jax.nn.gelu(s5_ssm(u, s5_a_re, s5_a_im, s5_log_dt, s5_b_re, s5_b_im, s5_c_re, s5_c_im,
                           s5_d).reshape(B, T, BRANCH_W))
    out_d = y * jax.nn.sigmoid(y @ s5_w_glu.astype(f32) + s5_b_glu.astype(f32))

    gates = jax.nn.sigmoid(gate_logits.astype(f32)).reshape(B, T, N_BRANCH, D_MODEL)
    branches = (out_a, out_b, out_c, out_d)
    merged = sum(gates[:, :, n] * (branches[n].astype(h.dtype) @ w_branch[n]) for n in range(N_BRANCH))
    return merged.astype(h.dtype) @ w_out


def memory_cross_attention(h, mem_n, wq, wk, wv, wo):
    B, T, _ = h.shape
    M = mem_n.shape[1]
    q = (h @ wq).reshape(B, T, XA_HEADS, XA_DIM)
    k = (mem_n @ wk).reshape(B, M, XA_HEADS, XA_DIM)
    v = (mem_n @ wv).reshape(B, M, XA_HEADS, XA_DIM)
    s = jnp.einsum('bthd,bmhd->bhtm', q, k).astype(jnp.float32) * XA_DIM ** -0.5
    p = jax.nn.softmax(s, axis=-1).astype(v.dtype)
    return jnp.einsum('bhtm,bmhd->bthd', p, v).reshape(B, T, D_MODEL) @ wo


def swiglu_ffn(h, w_in, w_out):
    a, b = jnp.split(h @ w_in, 2, axis=-1)
    return (jax.nn.silu(a) * b) @ w_out


def setup_inputs(seed: int = 0) -> dict:
    key = jax.random.key(seed)
    ks = iter(jax.random.split(key, 64))
    f32 = jnp.float32
    nrm = lambda shape, scale: scale * jax.random.normal(next(ks), shape, f32)
    gain = lambda shape: 1.0 + 0.1 * jax.random.normal(next(ks), shape, f32)
    L = DEPTH
    t = jnp.arange(SEQ, dtype=jnp.int32)
    starts = jax.random.bernoulli(next(ks), 1.0 / DOC_MEAN_LEN, (BATCH, SEQ)).at[:, 0].set(True)
    positions = (t - lax.cummax(jnp.where(starts, t, 0), axis=1)).astype(jnp.int32)
    return {
        'x': nrm((BATCH, SEQ, D_MODEL), 1.0),
        'mem': nrm((BATCH, MEM_LEN, D_MODEL), 1.0),
        'positions': positions,
        'norm_mix_pre': gain((L, D_MODEL)),
        'norm_mix_post': gain((L, D_MODEL)),
        'w_in': nrm((L, D_MODEL, N_IN), D_MODEL ** -0.5),
        'mla_q_norm': gain((L, MLA_Q_RANK)),
        'mla_w_uq': nrm((L, MLA_Q_RANK, MLA_HEADS * (MLA_NOPE + MLA_ROPE)), MLA_Q_RANK ** -0.5),
        'mla_kv_norm': gain((L, MLA_KV_RANK)),
        'mla_w_ukv': nrm((L, MLA_KV_RANK, MLA_HEADS * (MLA_NOPE + MLA_V)), MLA_KV_RANK ** -0.5),
        'hg_lb_logits': nrm((L, BRANCH_W), 0.1),
        'hg_out_norm': gain((L, BRANCH_W)),
        'ml_conv_w': nrm((L, ML_CONV, BRANCH_W), ML_CONV ** -0.5),
        'ml_conv_b': nrm((L, BRANCH_W), 0.01),
        'ml_w_q': nrm((L, ML_HEADS, ML_DIM, ML_DIM), ML_DIM ** -0.5),
        'ml_w_k': nrm((L, ML_HEADS, ML_DIM, ML_DIM), ML_DIM ** -0.5),
        'ml_i_bias': nrm((L, ML_HEADS), 0.1),
        'ml_f_bias': jnp.linspace(3.0, 6.0, ML_HEADS, dtype=f32)[None] + nrm((L, ML_HEADS), 0.1),
        'ml_out_norm': gain((L, BRANCH_W)),
        's5_a_re': -0.5 + nrm((L, S5_GROUPS, S5_STATE), 0.01),
        's5_a_im': jnp.pi * jnp.arange(S5_STATE, dtype=f32) + nrm((L, S5_GROUPS, S5_STATE), 0.01),
        's5_log_dt': jax.random.uniform(next(ks), (L, S5_GROUPS), f32,
                                        math.log(S5_DT_MIN), math.log(S5_DT_MAX)),
        's5_b_re': nrm((L, S5_GROUPS, S5_STATE, S5_GROUP_CH), (2 * S5_GROUP_CH) ** -0.5),
        's5_b_im': nrm((L, S5_GROUPS, S5_STATE, S5_GROUP_CH), (2 * S5_GROUP_CH) ** -0.5),
        's5_c_re': nrm((L, S5_GROUPS, S5_GROUP_CH, S5_STATE), S5_STATE ** -0.5),
        's5_c_im': nrm((L, S5_GROUPS, S5_GROUP_CH, S5_STATE), S5_STATE ** -0.5),
        's5_d': nrm((L, S5_GROUPS, S5_GROUP_CH), 1.0),
        's5_w_glu': nrm((L, BRANCH_W, BRANCH_W), BRANCH_W ** -0.5),
        's5_b_glu': nrm((L, BRANCH_W), 0.01),
        'w_branch': nrm((L, N_BRANCH, BRANCH_W, D_MODEL), BRANCH_W ** -0.5),
        'w_out': nrm((L, D_MODEL, D_MODEL), D_MODEL ** -0.5),
        'norm_xa_pre': gain((L, D_MODEL)),
        'norm_xa_post': gain((L, D_MODEL)),
        'norm_mem': gain((L, D_MODEL)),
        'xa_wq': nrm((L, D_MODEL, D_MODEL), D_MODEL ** -0.5),
        'xa_wk': nrm((L, D_MODEL, D_MODEL), D_MODEL ** -0.5),
        'xa_wv': nrm((L, D_MODEL, D_MODEL), D_MODEL ** -0.5),
        'xa_wo': nrm((L, D_MODEL, D_MODEL), D_MODEL ** -0.5),
        'norm_ffn_pre': gain((L, D_MODEL)),
        'norm_ffn_post': gain((L, D_MODEL)),
        'ffn_w_in': nrm((L, D_MODEL, 2 * D_FF), D_MODEL ** -0.5),
        'ffn_w_out': nrm((L, D_FF, D_MODEL), D_FF ** -0.5),
    }


def reference(x, mem, positions, norm_mix_pre, norm_mix_post, w_in, mla_q_norm, mla_w_uq,
              mla_kv_norm, mla_w_ukv, hg_lb_logits, hg_out_norm, ml_conv_w, ml_conv_b, ml_w_q,
              ml_w_k, ml_i_bias, ml_f_bias, ml_out_norm, s5_a_re, s5_a_im, s5_log_dt, s5_b_re,
              s5_b_im, s5_c_re, s5_c_im, s5_d, s5_w_glu, s5_b_glu, w_branch, w_out, norm_xa_pre,
              norm_xa_post, norm_mem, xa_wq, xa_wk, xa_wv, xa_wo, norm_ffn_pre, norm_ffn_post,
              ffn_w_in, ffn_w_out):
    lb_soft = jax.nn.softmax(hg_lb_logits.astype(jnp.float32), axis=0)
    lower_bounds = jnp.cumsum(lb_soft, axis=0) - lb_soft[0]
    for l in range(DEPTH):
        h = rms_norm(x, norm_mix_pre[l])
        mix = hybrid_token_mixer(h, positions, lower_bounds[l], w_in[l], mla_q_norm[l], mla_w_uq[l],
                                 mla_kv_norm[l], mla_w_ukv[l], hg_out_norm[l], ml_conv_w[l],
                                 ml_conv_b[l], ml_w_q[l], ml_w_k[l], ml_i_bias[l], ml_f_bias[l],
                                 ml_out_norm[l], s5_a_re[l], s5_a_im[l], s5_log_dt[l], s5_b_re[l],
                                 s5_b_im[l], s5_c_re[l], s5_c_im[l], s5_d[l], s5_w_glu[l],
                                 s5_b_glu[l], w_branch[l], w_out[l])
        x = x + rms_norm(mix, norm_mix_post[l])
        h = rms_norm(x, norm_xa_pre[l])
        xa = memory_cross_attention(h, rms_norm(mem, norm_mem[l]), xa_wq[l], xa_wk[l], xa_wv[l], xa_wo[l])
        x = x + rms_norm(xa, norm_xa_post[l])
        h = rms_norm(x, norm_ffn_pre[l])
        x = x + rms_norm(swiglu_ffn(h, ffn_w_in[l], ffn_w_out[l]), norm_ffn_post[l])
    return x
```

```cpp
#include <hip/hip_runtime.h>
#include <cstdio>
#include <cstdint>
constexpr int BATCH = 8, T = 2048, D = 1024, DEPTH = 4, M = BATCH * T, MEM = 256, MM = BATCH * MEM;
constexpr int N_IN = 6568, NP = 6656, DFF = 2816;
constexpr float EPS = 1e-6f;
constexpr int PQ = 0, PKV = 256, PKR = 384, PIG = 416, PFG = 420, PBQ = 512, PBF = 768, PBI = 1024, PBG = 1280, PCX = 1536, PCV = 1792, PCO = 2048, PDU = 2304, PG = 2560;
typedef unsigned short bf16;
typedef unsigned v4u __attribute__((ext_vector_type(4)));
typedef unsigned v2u __attribute__((ext_vector_type(2)));
typedef float f32x4 __attribute__((ext_vector_type(4)));
typedef short bf16x8 __attribute__((ext_vector_type(8)));
#define LAS __attribute__((address_space(3)))
#define GAS __attribute__((address_space(1)))
__device__ __forceinline__ float bf2f(bf16 v) { return __uint_as_float(((unsigned)v) << 16); }
__device__ __forceinline__ unsigned f2bf(float f) { unsigned u = __float_as_uint(f); return (u + 0x7fffu + ((u >> 16) & 1u)) >> 16; }
__device__ __forceinline__ unsigned pk2(float lo, float hi) { return f2bf(lo) | (f2bf(hi) << 16); }
__device__ __forceinline__ float sigmoidf_(float x) { return 1.f / (1.f + __expf(-x)); }
__device__ __forceinline__ float siluf_(float x) { return x * sigmoidf_(x); }
__device__ __forceinline__ float wave_sum(float v) {
#pragma unroll
    for (int o = 1; o < 64; o <<= 1) v += __shfl_xor(v, o);
    return v;
}
__device__ __forceinline__ float wave_max(float v) {
#pragma unroll
    for (int o = 1; o < 64; o <<= 1) v = fmaxf(v, __shfl_xor(v, o));
    return v;
}
__host__ __device__ __forceinline__ int win_src(int n) {
    if (n < 416) return n;
    if (n < 420) return 2208 + (n - 416);
    if (n < 424) return 2212 + (n - 420);
    if (n < 512) return -1;
    if (n < 2304) return 416 + (n - 512);
    if (n < 2560) return 2216 + (n - 2304);
    return 2472 + (n - 2560);
}
__host__ __device__ __forceinline__ int ffn_src(int n) { const int t = n >> 8, w = n & 255; return w < 128 ? t * 128 + w : DFF + t * 128 + (w - 128); }
namespace pg8 {
#define PG8_LAS __attribute__((address_space(3)))
typedef unsigned short bf16_t;
typedef short bf16x8 __attribute__((ext_vector_type(8)));
typedef float f32x4 __attribute__((ext_vector_type(4)));
typedef unsigned u32x4 __attribute__((ext_vector_type(4)));
constexpr int BM = 256, BK = 64, HALF = 128, HTB = HALF * BK * 2  , STAGE_BYTES = 8 * HTB, NXCD = 8, WGM = 8;

__host__ __device__ __forceinline__ int lds_byte(int r, int c) { const int st = (r >> 4) * 2 + (c >> 5), rr = r & 15, cc = c & 31, ob = rr * 64 + cc * 2; return st * 1024 + (ob ^ (((ob >> 9) & 1) << 5)); }
__host__ __device__ __forceinline__ void stage_rc(int b, int& R, int& C) { const int st = b / 1024, sb = b % 1024, swz = sb ^ (((sb >> 9) & 1) << 5); R = (st >> 1) * 16 + swz / 64; C = (st & 1) * 32 + (swz % 64) / 2; }
__host__ __device__ __forceinline__ int perm32(int rho) { const int n = rho >> 4, i = rho & 15; return 8 * (i >> 2) + 4 * n + (i & 3); }

struct Unit { int pm, pn; };
struct Gemm { const bf16_t* A; const bf16_t* Bt; int M, N, K, lda, ldb, pad; };

struct StaticOrder {
    int nM, nN, nwg, G, c;
    __host__ __device__ void init(int M, int N, int G_, int c_) { nM = M / BM; nN = N / BM; nwg = nM * nN; G = G_; c = c_; }
    __host__ __device__ bool next(int i, Unit& u) const {
        const long L = (long)i * G + c; if (L >= nwg) return false;
        int wgid = (int)L; { const int q = nwg / NXCD, r = nwg % NXCD, xcd = wgid % NXCD, off = wgid / NXCD; wgid = (xcd < r ? xcd * (q + 1) : r * (q + 1) + (xcd - r) * q) + off; }
        const int nig = WGM * nN, gid = wgid / nig, fm = gid * WGM, gsz = (nM - fm) < WGM ? (nM - fm) : WGM;
        u.pm = fm + ((wgid % nig) % gsz); u.pn = (wgid % nig) / gsz; return true;
    }
    __device__ __forceinline__ void a_ready(const Unit&) const {}
    __device__ __forceinline__ void done(const Unit&) const {}
};

__device__ __forceinline__ unsigned cvt_pk_bf16(float lo, float hi) { unsigned r; asm volatile("v_cvt_pk_bf16_f32 %0, %1, %2" : "=v"(r) : "v"(lo), "v"(hi)); return r; }
typedef float f32x2 __attribute__((ext_vector_type(2)));
template <class Epi, class Sched, bool ALIGN_EPI = false, bool SP2 = false>
__device__ __forceinline__ void gemm_phase(PG8_LAS unsigned char* lds, const Gemm g, const Sched& S, const Epi& E) {
    const int tid = threadIdx.x, wid = __builtin_amdgcn_readfirstlane(tid >> 6), lane = tid & 63, wr = wid >> 2, wc = wid & 3, fr = lane & 15, fq = lane >> 4;
    const int K = g.K, nt = K / BK;
    unsigned voffA[2], voffB[2];
#pragma unroll
    for (int i = 0; i < 2; ++i) { int R, C; stage_rc(tid * 16 + i * 8192, R, C); const int Rb = Epi::PERM ? ((R & ~31) + perm32(R & 31)) : R;
        voffA[i] = (unsigned)(R * g.lda + C) * 2u; voffB[i] = (unsigned)(Rb * g.ldb + C) * 2u; }
    const size_t kstep = (size_t)(BK * 2);
    const size_t hstepA = (size_t)HALF * g.lda * 2, hstepB = (size_t)HALF * g.ldb * 2;
    const size_t tstepA = 2 * hstepA, tstepB = 2 * hstepB;
    const unsigned ldsw = (unsigned)wid * 1024u;
    const int aoff = lds_byte(wr * 64 + fr, fq * 8), boff = lds_byte(wc * 32 + fr, fq * 8);
#define PG8_SA(b, h) (((b) * 2 + (h)) * HTB)
#define PG8_SB(b, h) ((4 + (b) * 2 + (h)) * HTB)
#define PG8_STAGE(bufoff, gbase, voff) do { _Pragma("unroll") for (int _i = 0; _i < 2; ++_i) \
        __builtin_amdgcn_global_load_lds((const unsigned*)((const char*)(gbase) + (voff)[_i]), (PG8_LAS unsigned*)(lds + (bufoff) + ldsw + _i * 8192), 16, 0, 0); } while (0)
#define PG8_LDA(dst, b, h) do { _Pragma("unroll") for (int m = 0; m < 4; ++m) _Pragma("unroll") for (int k = 0; k < 2; ++k) dst[m][k] = *(const PG8_LAS bf16x8*)(lds + PG8_SA(b, h) + aoff + m * 2048 + k * 1024); } while (0)
#define PG8_LDB(dst, b, h) do { _Pragma("unroll") for (int n = 0; n < 2; ++n) _Pragma("unroll") for (int k = 0; k < 2; ++k) dst[n][k] = *(const PG8_LAS bf16x8*)(lds + PG8_SB(b, h) + boff + n * 2048 + k * 1024); } while (0)
#define PG8_MMA(ai, bj, At, Bt) do { __builtin_amdgcn_s_setprio(1); _Pragma("unroll") for (int m = 0; m < 4; ++m) _Pragma("unroll") for (int n = 0; n < 2; ++n) _Pragma("unroll") for (int k = 0; k < 2; ++k) \
        acc[ai][bj][m][n] = __builtin_amdgcn_mfma_f32_16x16x32_bf16(Bt[n][k], At[m][k], acc[ai][bj][m][n], 0, 0, 0); __builtin_amdgcn_s_setprio(0); } while (0)
#define PG8_WAIT_V(n) asm volatile("s_waitcnt vmcnt(" #n ")" ::: "memory")
#define PG8_WAIT_L(n) asm volatile("s_waitcnt lgkmcnt(" #n ")" ::: "memory")
#define PG8_BAR __builtin_amdgcn_s_barrier()
#define PG8_SCHED __builtin_amdgcn_sched_barrier(0)
    Unit cur, nxt; int ui = 0;
    if (!S.next(0, cur)) return;
    f32x4 acc[2][2][4][2];
#pragma unroll
    for (int a = 0; a < 2; ++a)
#pragma unroll
        for (int b = 0; b < 2; ++b)
#pragma unroll
            for (int m = 0; m < 4; ++m)
#pragma unroll
                for (int n = 0; n < 2; ++n) acc[a][b][m][n] = (f32x4){0.f, 0.f, 0.f, 0.f};
    bf16x8 At[4][2], B0[2][2], B1[2][2];
    const char* cA = (const char*)g.A + (size_t)cur.pm * tstepA; const char* cB = (const char*)g.Bt + (size_t)cur.pn * tstepB;
    S.a_ready(cur);
    if constexpr (SP2) {
        PG8_STAGE(PG8_SB(0, 0), cB, voffB); PG8_STAGE(PG8_SB(0, 1), cB + hstepB, voffB); PG8_STAGE(PG8_SA(0, 0), cA, voffA); PG8_STAGE(PG8_SA(0, 1), cA + hstepA, voffA);
        if (wr == 1) PG8_BAR;
        PG8_WAIT_V(2); PG8_BAR;
        PG8_STAGE(PG8_SB(1, 0), cB + kstep, voffB); PG8_STAGE(PG8_SA(1, 0), cA + kstep, voffA); PG8_STAGE(PG8_SB(1, 1), cB + hstepB + kstep, voffB);
        PG8_WAIT_V(6); PG8_BAR;
    } else {
        PG8_STAGE(PG8_SB(0, 0), cB, voffB); PG8_STAGE(PG8_SA(0, 0), cA, voffA); PG8_STAGE(PG8_SB(0, 1), cB + hstepB, voffB); PG8_STAGE(PG8_SA(0, 1), cA + hstepA, voffA);
        if (wr == 1) PG8_BAR;
        PG8_WAIT_V(4); PG8_BAR;
        PG8_STAGE(PG8_SB(1, 0), cB + kstep, voffB); PG8_STAGE(PG8_SA(1, 0), cA + kstep, voffA); PG8_STAGE(PG8_SB(1, 1), cB + hstepB + kstep, voffB);
        PG8_WAIT_V(6); PG8_BAR;
    }
    for (;;) {
        const bool has_next = S.next(ui + 1, nxt);
        const char* nA = has_next ? (const char*)g.A + (size_t)nxt.pm * tstepA : cA; const char* nB = has_next ? (const char*)g.Bt + (size_t)nxt.pn * tstepB : cB;
        for (int t = 0; t < nt; t += 2) {
            const bool last = (t == nt - 2);
            const char* a1 = cA + (size_t)(t + 1) * kstep;
            const char* a2 = last ? nA : cA + (size_t)(t + 2) * kstep; const char* b2 = last ? nB : cB + (size_t)(t + 2) * kstep;
            const char* a3 = a2 + kstep; const char* b3 = b2 + kstep;
            if (last && has_next) S.a_ready(nxt);
            if constexpr (SP2) {
            PG8_LDB(B0, 0, 0); PG8_LDB(B1, 0, 1); PG8_SCHED; PG8_LDA(At, 0, 0); PG8_STAGE(PG8_SA(1, 1), a1 + hstepA, voffA);
            PG8_WAIT_V(8); PG8_WAIT_L(0); PG8_BAR; PG8_MMA(0, 0, At, B0); PG8_MMA(0, 1, At, B1); PG8_BAR; PG8_SCHED;
            PG8_LDA(At, 0, 1); PG8_STAGE(PG8_SB(0, 0), b2, voffB); PG8_STAGE(PG8_SB(0, 1), b2 + hstepB, voffB); PG8_STAGE(PG8_SA(0, 0), a2, voffA);
            PG8_WAIT_V(8); PG8_WAIT_L(0); PG8_BAR; PG8_MMA(1, 0, At, B0); PG8_MMA(1, 1, At, B1); PG8_BAR; PG8_SCHED;
            PG8_LDB(B0, 1, 0); PG8_LDB(B1, 1, 1); PG8_SCHED; PG8_LDA(At, 1, 0); PG8_STAGE(PG8_SA(0, 1), a2 + hstepA, voffA);
            PG8_WAIT_V(8); PG8_WAIT_L(0); PG8_BAR; PG8_MMA(0, 0, At, B0); PG8_MMA(0, 1, At, B1); PG8_BAR; PG8_SCHED;
            PG8_LDA(At, 1, 1); PG8_STAGE(PG8_SB(1, 0), b3, voffB); PG8_STAGE(PG8_SB(1, 1), b3 + hstepB, voffB); PG8_STAGE(PG8_SA(1, 0), a3, voffA);
            PG8_WAIT_V(8); PG8_WAIT_L(0); PG8_BAR; PG8_MMA(1, 0, At, B0); PG8_MMA(1, 1, At, B1); PG8_BAR; PG8_SCHED;
            } else {
            PG8_LDB(B0, 0, 0); PG8_SCHED; PG8_LDA(At, 0, 0); PG8_STAGE(PG8_SA(1, 1), a1 + hstepA, voffA);
            PG8_WAIT_L(8); PG8_BAR; PG8_WAIT_L(0); PG8_MMA(0, 0, At, B0); PG8_BAR; PG8_SCHED;
            PG8_LDB(B1, 0, 1); PG8_STAGE(PG8_SB(0, 0), b2, voffB);
            PG8_BAR; PG8_WAIT_L(0); PG8_MMA(0, 1, At, B1); PG8_BAR;
            PG8_LDA(At, 0, 1); PG8_STAGE(PG8_SA(0, 0), a2, voffA);
            PG8_BAR; PG8_WAIT_L(0); PG8_MMA(1, 0, At, B0); PG8_BAR; PG8_SCHED;
            PG8_STAGE(PG8_SB(0, 1), b2 + hstepB, voffB);
            PG8_WAIT_V(6); PG8_BAR; PG8_MMA(1, 1, At, B1); PG8_BAR;
            PG8_LDB(B0, 1, 0); PG8_SCHED; PG8_LDA(At, 1, 0); PG8_STAGE(PG8_SA(0, 1), a2 + hstepA, voffA);
            PG8_WAIT_L(8); PG8_BAR; PG8_WAIT_L(0); PG8_MMA(0, 0, At, B0); PG8_BAR; PG8_SCHED;
            PG8_LDB(B1, 1, 1); PG8_STAGE(PG8_SB(1, 0), b3, voffB);
            PG8_BAR; PG8_WAIT_L(0); PG8_MMA(0, 1, At, B1); PG8_BAR;
            PG8_LDA(At, 1, 1); PG8_STAGE(PG8_SA(1, 0), a3, voffA);
            PG8_BAR; PG8_WAIT_L(0); PG8_MMA(1, 0, At, B0); PG8_BAR; PG8_SCHED;
            PG8_STAGE(PG8_SB(1, 1), b3 + hstepB, voffB);
            PG8_WAIT_V(6); PG8_BAR; PG8_MMA(1, 1, At, B1); PG8_BAR;
            }
        }
        if constexpr (ALIGN_EPI) { if (wr == 0) PG8_BAR; }
        if constexpr (!Epi::AFTER_DRAIN) { E(acc, cur, wr, wc, fr, fq); S.done(cur); }
        if (!has_next) break;
#pragma unroll
        for (int a = 0; a < 2; ++a)
#pragma unroll
            for (int b = 0; b < 2; ++b)
#pragma unroll
                for (int m = 0; m < 4; ++m)
#pragma unroll
                    for (int n = 0; n < 2; ++n) acc[a][b][m][n] = (f32x4){0.f, 0.f, 0.f, 0.f};
        cur = nxt; cA = nA; cB = nB; ++ui;
        if constexpr (ALIGN_EPI) { if (wr == 1) PG8_BAR; }
    }
    PG8_WAIT_V(0);
    if constexpr (!ALIGN_EPI) { if (wr == 0) PG8_BAR; }
    PG8_BAR;
    if constexpr (Epi::AFTER_DRAIN) { E.fused(acc, cur, wr, wc, fr, fq, lds, wid, lane); S.done(cur); }
#undef PG8_SA
#undef PG8_SB
#undef PG8_STAGE
#undef PG8_LDA
#undef PG8_LDB
#undef PG8_MMA
#undef PG8_WAIT_V
#undef PG8_WAIT_L
#undef PG8_BAR
#undef PG8_SCHED
}
}
namespace pg8 {
struct EpiStoreBf16 {
    static constexpr bool PERM = true, AFTER_DRAIN = false;
    bf16_t* O; int ldc; int pad;
    __device__ __forceinline__ void operator()(const f32x4 (&acc)[2][2][4][2], const Unit& u, int wr, int wc, int fr, int fq) const {
        const int row0 = u.pm * BM + wr * 64 + fr, col0 = u.pn * BM + wc * 32 + 8 * fq;
#pragma unroll
        for (int ai = 0; ai < 2; ++ai)
#pragma unroll
            for (int m = 0; m < 4; ++m) { bf16_t* rowp = O + (size_t)(row0 + ai * HALF + m * 16) * ldc + col0;
#pragma unroll
                for (int bj = 0; bj < 2; ++bj) { const f32x4 v0 = acc[ai][bj][m][0], v1 = acc[ai][bj][m][1];
                    u32x4 w; w.x = cvt_pk_bf16(v0[0], v0[1]); w.y = cvt_pk_bf16(v0[2], v0[3]); w.z = cvt_pk_bf16(v1[0], v1[1]); w.w = cvt_pk_bf16(v1[2], v1[3]);
                    *(u32x4*)(rowp + bj * HALF) = w; } }
    }
};
struct EpiStoreF32 {
    static constexpr bool PERM = false, AFTER_DRAIN = false;
    float* O; int ldc; int pad;
    __device__ __forceinline__ void operator()(const f32x4 (&acc)[2][2][4][2], const Unit& u, int wr, int wc, int fr, int fq) const {
        const int row0 = u.pm * BM + wr * 64 + fr, col0 = u.pn * BM + wc * 32 + 4 * fq;
#pragma unroll
        for (int ai = 0; ai < 2; ++ai)
#pragma unroll
            for (int m = 0; m < 4; ++m) { float* rowp = O + (size_t)(row0 + ai * HALF + m * 16) * ldc + col0;
#pragma unroll
                for (int bj = 0; bj < 2; ++bj)
#pragma unroll
                    for (int n = 0; n < 2; ++n) *(f32x4*)(rowp + bj * HALF + n * 16) = acc[ai][bj][m][n]; }
    }
};
struct EpiSwiglu {
    static constexpr bool PERM = true, AFTER_DRAIN = false;
    bf16_t* O; int ldc; int pad;
    __device__ __forceinline__ void operator()(const f32x4 (&acc)[2][2][4][2], const Unit& u, int wr, int wc, int fr, int fq) const {
        const int row0 = u.pm * BM + wr * 64 + fr, col0 = u.pn * HALF + wc * 32 + 8 * fq;
#pragma unroll
        for (int ai = 0; ai < 2; ++ai)
#pragma unroll
            for (int m = 0; m < 4; ++m) { bf16_t* rowp = O + (size_t)(row0 + ai * HALF + m * 16) * ldc + col0;
                float h[8];
#pragma unroll
                for (int n = 0; n < 2; ++n)
#pragma unroll
                    for (int i = 0; i < 4; ++i) { const float a = acc[ai][0][m][n][i], b = acc[ai][1][m][n][i]; h[n * 4 + i] = a / (1.f + __expf(-a)) * b; }
                u32x4 w; w.x = cvt_pk_bf16(h[0], h[1]); w.y = cvt_pk_bf16(h[2], h[3]); w.z = cvt_pk_bf16(h[4], h[5]); w.w = cvt_pk_bf16(h[6], h[7]);
                *(u32x4*)rowp = w; }
    }
};
struct EpiGate {
    static constexpr bool PERM = false, AFTER_DRAIN = false;
    bf16_t* O; const bf16_t* G; int ldg; int br;
    __device__ __forceinline__ void operator()(const f32x4 (&acc)[2][2][4][2], const Unit& u, int wr, int wc, int fr, int fq) const {
        const int row0 = u.pm * BM + wr * 64 + fr, col0 = u.pn * BM + wc * 32 + 4 * fq;
#pragma unroll
        for (int ai = 0; ai < 2; ++ai)
#pragma unroll
            for (int m = 0; m < 4; ++m) { const size_t row = (size_t)(row0 + ai * HALF + m * 16);
#pragma unroll
                for (int bj = 0; bj < 2; ++bj)
#pragma unroll
                    for (int n = 0; n < 2; ++n) { const int col = col0 + bj * HALF + n * 16;
                        const unsigned long long gw = *(const unsigned long long*)(G + row * ldg + col);
                        f32x4 o = acc[ai][bj][m][n];
#pragma unroll
                        for (int i = 0; i < 4; ++i) { const float g = __uint_as_float((unsigned)((gw >> (16 * i)) & 0xffffull) << 16); o[i] = o[i] / (1.f + __expf(-g)); }
                        unsigned long long* op = (unsigned long long*)(O + row * 1024 + col);
                        if (br > 0) { const unsigned long long pw = *op;
#pragma unroll
                            for (int i = 0; i < 4; ++i) o[i] += __uint_as_float((unsigned)((pw >> (16 * i)) & 0xffffull) << 16); }
                        *op = (unsigned long long)cvt_pk_bf16(o[0], o[1]) | ((unsigned long long)cvt_pk_bf16(o[2], o[3]) << 32); }
            }
    }
};
}
template <class Epi> __global__ void __launch_bounds__(512, 2) gemm_kernel(pg8::Gemm g, Epi E) {
    extern __shared__ __attribute__((aligned(16))) unsigned char lds[];
    pg8::StaticOrder S; S.init(g.M, g.N, gridDim.x, blockIdx.x);
    pg8::gemm_phase<Epi, pg8::StaticOrder, true, true>((PG8_LAS unsigned char*)lds, g, S, E);
}
__global__ void __launch_bounds__(256) k_convert_wt(const float* __restrict__ W, int K, int ldw, int col0, bf16* __restrict__ Wt, int N, int mode) {
    __shared__ float tile[64][65];
    const int n0 = blockIdx.x * 64, k0 = blockIdx.y * 64, tid = threadIdx.x;
    for (int i = tid; i < 64 * 64; i += 256) { const int kk = i >> 6, nn = i & 63; const int n = n0 + nn;
        int src = mode == 0 ? col0 + n : (mode == 1 ? win_src(n) : ffn_src(n));
        tile[kk][nn] = (n < N && src >= 0) ? W[(size_t)(k0 + kk) * ldw + src] : 0.f; }
    __syncthreads();
    for (int i = tid; i < 64 * 32; i += 256) { const int nn = i >> 5, kp = (i & 31) * 2; const int n = n0 + nn;
        if (n < N) *(unsigned*)(Wt + (size_t)n * K + k0 + kp) = pk2(tile[kp][nn], tile[kp + 1][nn]); }
}
__global__ void k_convert_plain(const float* __restrict__ src, bf16* __restrict__ dst, size_t n) {
    for (size_t i = (size_t)blockIdx.x * blockDim.x + threadIdx.x; i < n; i += (size_t)gridDim.x * blockDim.x) dst[i] = (bf16)f2bf(src[i]);
}
__global__ void __launch_bounds__(256) k_rmsnorm_rows(const float* __restrict__ x, const float* __restrict__ g, bf16* __restrict__ out, int rows) {
    const int lane = threadIdx.x & 63, row = blockIdx.x * 4 + (threadIdx.x >> 6); if (row >= rows) return;
    const f32x4* xr = (const f32x4*)(x + (size_t)row * D) + lane; f32x4 v[4]; float s = 0.f;
#pragma unroll
    for (int j = 0; j < 4; ++j) { v[j] = xr[64 * j]; s += v[j].x * v[j].x + v[j].y * v[j].y + v[j].z * v[j].z + v[j].w * v[j].w; }
    const float rstd = rsqrtf(wave_sum(s) * (1.f / D) + EPS);
    v2u* o = (v2u*)(out + (size_t)row * D) + lane;
#pragma unroll
    for (int j = 0; j < 4; ++j) { const f32x4 gg = ((const f32x4*)g)[lane + 64 * j]; v2u w; w.x = pk2(v[j].x * rstd * gg.x, v[j].y * rstd * gg.y); w.y = pk2(v[j].z * rstd * gg.z, v[j].w * rstd * gg.w); o[64 * j] = w; }
}
__global__ void __launch_bounds__(256) k_resid_norm(float* __restrict__ x, const float* __restrict__ y, const float* __restrict__ g1, const float* __restrict__ g2, bf16* __restrict__ xn) {
    const int lane = threadIdx.x & 63, row = blockIdx.x * 4 + (threadIdx.x >> 6);
    const f32x4* yr = (const f32x4*)(y + (size_t)row * D) + lane; f32x4* xr = (f32x4*)(x + (size_t)row * D) + lane; f32x4 v[4], xv[4]; float s = 0.f;
#pragma unroll
    for (int j = 0; j < 4; ++j) { v[j] = yr[64 * j]; s += v[j].x * v[j].x + v[j].y * v[j].y + v[j].z * v[j].z + v[j].w * v[j].w; }
    const float rstd = rsqrtf(wave_sum(s) * (1.f / D) + EPS); float s2 = 0.f;
#pragma unroll
    for (int j = 0; j < 4; ++j) { const f32x4 gg = ((const f32x4*)g1)[lane + 64 * j]; xv[j] = xr[64 * j] + v[j] * rstd * gg; xr[64 * j] = xv[j];
        s2 += xv[j].x * xv[j].x + xv[j].y * xv[j].y + xv[j].z * xv[j].z + xv[j].w * xv[j].w; }
    if (g2) { const float r2 = rsqrtf(wave_sum(s2) * (1.f / D) + EPS); v2u* o = (v2u*)(xn + (size_t)row * D) + lane;
#pragma unroll
        for (int j = 0; j < 4; ++j) { const f32x4 gg = ((const f32x4*)g2)[lane + 64 * j]; v2u w; w.x = pk2(xv[j].x * r2 * gg.x, xv[j].y * r2 * gg.y); w.y = pk2(xv[j].z * r2 * gg.z, xv[j].w * r2 * gg.w); o[64 * j] = w; } }
}
__global__ void __launch_bounds__(256) k_mla_proj_naive(const bf16* __restrict__ P, const int* __restrict__ pos, const float* __restrict__ qn, const float* __restrict__ wuq,
                                                        const float* __restrict__ kvn, const float* __restrict__ wukv, float* __restrict__ Qm, float* __restrict__ KVm, float* __restrict__ Kr) {
    __shared__ float aq[256], akv[128], qs[384], red[4];
    const int tok = blockIdx.x, tid = threadIdx.x; const bf16* p = P + (size_t)tok * NP;
    float v = bf2f(p[PQ + tid]); float s = wave_sum(v * v); if ((tid & 63) == 0) red[tid >> 6] = s; __syncthreads();
    const float rq = rsqrtf((red[0] + red[1] + red[2] + red[3]) * (1.f / 256) + EPS); aq[tid] = v * rq * qn[tid]; __syncthreads();
    float v2 = tid < 128 ? bf2f(p[PKV + tid]) : 0.f; float s2 = wave_sum(v2 * v2); if ((tid & 63) == 0) red[tid >> 6] = s2; __syncthreads();
    const float rk = rsqrtf((red[0] + red[1]) * (1.f / 128) + EPS); if (tid < 128) akv[tid] = v2 * rk * kvn[tid]; __syncthreads();
    for (int c = tid; c < 384; c += 256) { float a = 0.f; for (int k = 0; k < 256; ++k) a += aq[k] * wuq[k * 384 + c]; qs[c] = a; }
    for (int c = tid; c < 512; c += 256) { float a = 0.f; for (int k = 0; k < 128; ++k) a += akv[k] * wukv[k * 512 + c]; KVm[(size_t)tok * 512 + c] = a; }
    __syncthreads();
    const float ps = (float)pos[tok]; const float scale = 0.10206207261596577f;
    for (int c = tid; c < 384; c += 256) { const int h = c / 96, j = c % 96; float o;
        if (j < 64) o = qs[c];
        else { const int jj = (j - 64) & 15; const float ang = ps * powf(10000.f, -(float)jj / 16.f); const float cs = cosf(ang), sn = sinf(ang);
            const float x1 = qs[h * 96 + 64 + jj], x2 = qs[h * 96 + 80 + jj]; o = (j < 80) ? x1 * cs - x2 * sn : x2 * cs + x1 * sn; }
        Qm[(size_t)tok * 384 + c] = o * scale; }
    if (tid < 32) { const int jj = tid & 15; const float ang = ps * powf(10000.f, -(float)jj / 16.f); const float cs = cosf(ang), sn = sinf(ang);
        const float x1 = bf2f(p[PKR + jj]), x2 = bf2f(p[PKR + 16 + jj]); Kr[(size_t)tok * 32 + tid] = tid < 16 ? x1 * cs - x2 * sn : x2 * cs + x1 * sn; }
}
__global__ void __launch_bounds__(64) k_mla_attn_naive(const float* __restrict__ Qm, const float* __restrict__ KVm, const float* __restrict__ Kr, bf16* __restrict__ BR) {
    __shared__ float Ks[32][96], Vs[32][64];
    const int qb = blockIdx.x, h = blockIdx.y, b = blockIdx.z, tid = threadIdx.x; const int t = qb * 64 + tid; const size_t tok = (size_t)b * T + t;
    float q[96], o[64]; for (int j = 0; j < 96; ++j) q[j] = Qm[tok * 384 + h * 96 + j]; for (int e = 0; e < 64; ++e) o[e] = 0.f;
    float mx = -1e30f, l = 0.f;
    for (int k0 = 0; k0 < (qb + 1) * 64; k0 += 32) {
        __syncthreads();
        for (int i = tid; i < 32 * 96; i += 64) { const int kk = i / 96, j = i % 96; const size_t kt = (size_t)b * T + k0 + kk; Ks[kk][j] = j < 64 ? KVm[kt * 512 + h * 128 + j] : Kr[kt * 32 + (j - 64)]; }
        for (int i = tid; i < 32 * 64; i += 64) { const int kk = i / 64, e = i % 64; const size_t kt = (size_t)b * T + k0 + kk; Vs[kk][e] = KVm[kt * 512 + h * 128 + 64 + e]; }
        __syncthreads();
        for (int kk = 0; kk < 32; ++kk) { if (k0 + kk > t) break;
            float s = 0.f; for (int j = 0; j < 96; ++j) s += q[j] * Ks[kk][j];
            const float mn = fmaxf(mx, s), c = __expf(mx - mn), pw = __expf(s - mn); l = l * c + pw;
            for (int e = 0; e < 64; ++e) o[e] = o[e] * c + pw * Vs[kk][e]; mx = mn; }
    }
    const float il = 1.f / l; for (int e = 0; e < 64; ++e) BR[tok * 1024 + h * 64 + e] = (bf16)f2bf(o[e] * il);
}
__global__ void __launch_bounds__(256) k_hgrn2_naive(const bf16* __restrict__ P, const float* __restrict__ lb, const float* __restrict__ onorm, bf16* __restrict__ BR) {
    __shared__ float fs[64], ks[64], qs[64], vs[64], part[4][64], red[1];
    const int h = blockIdx.x, b = blockIdx.y, tid = threadIdx.x, e = tid & 63, dq = tid >> 6;
    float S[16]; for (int j = 0; j < 16; ++j) S[j] = 0.f;
    for (int t = 0; t < T; ++t) { const bf16* p = P + ((size_t)b * T + t) * NP;
        if (tid < 64) { const int c = h * 64 + tid; const float l = lb[c], fl = bf2f(p[PBF + c]); const float sg = sigmoidf_(fl);
            fs[tid] = fmaxf(l + (1.f - l) * sg, 1e-30f); ks[tid] = (1.f - l) * (1.f - sg); qs[tid] = siluf_(bf2f(p[PBQ + c])); vs[tid] = bf2f(p[PBI + c]); }
        __syncthreads();
        float po = 0.f; const float ve = vs[e];
#pragma unroll
        for (int j = 0; j < 16; ++j) { const int d = dq * 16 + j; S[j] = fs[d] * S[j] + ks[d] * ve; po += qs[d] * S[j]; }
        part[dq][e] = po; __syncthreads();
        if (tid < 64) { const float o = part[0][tid] + part[1][tid] + part[2][tid] + part[3][tid]; const float ss = wave_sum(o * o);
            const float r = rsqrtf(ss * (1.f / 64) + EPS); const int c = h * 64 + tid;
            BR[((size_t)b * T + t) * 1024 + 256 + c] = (bf16)f2bf(o * r * onorm[c] * siluf_(bf2f(p[PBG + c]))); }
        __syncthreads();
    }
}
__global__ void __launch_bounds__(256) k_ml_proj_naive(const bf16* __restrict__ P, const float* __restrict__ cw, const float* __restrict__ cb, const float* __restrict__ wq, const float* __restrict__ wk,
                                                       float* __restrict__ QKml) {
    __shared__ float xc[256];
    const int tok = blockIdx.x, tid = threadIdx.x, t = tok % T; float a = cb[tid];
    for (int j = 0; j < 4; ++j) { const int tt = t - 3 + j; if (tt >= 0) a += cw[j * 256 + tid] * bf2f(P[(size_t)(tok - 3 + j) * NP + PCX + tid]); }
    xc[tid] = siluf_(a); __syncthreads();
    const int h = tid >> 6, e = tid & 63; float q = 0.f, k = 0.f;
    for (int d = 0; d < 64; ++d) { const float xv = xc[h * 64 + d]; q += xv * wq[(h * 64 + d) * 64 + e]; k += xv * wk[(h * 64 + d) * 64 + e]; }
    QKml[(size_t)tok * 512 + tid] = q; QKml[(size_t)tok * 512 + 256 + tid] = k * 0.125f;
}
__global__ void __launch_bounds__(256) k_mlstm_naive(const bf16* __restrict__ P, const float* __restrict__ QKml, const float* __restrict__ ib, const float* __restrict__ fb, const float* __restrict__ onorm, bf16* __restrict__ BR) {
    __shared__ float ks[64], qs[64], vs[64], part[4][64], gate[2], den_s[1];
    const int h = blockIdx.x, b = blockIdx.y, tid = threadIdx.x, e = tid & 63, dq = tid >> 6;
    float C[16]; for (int j = 0; j < 16; ++j) C[j] = 0.f; float n = 0.f;
    for (int t = 0; t < T; ++t) { const size_t tok = (size_t)b * T + t; const bf16* p = P + tok * NP;
        if (tid < 64) { qs[tid] = QKml[tok * 512 + h * 64 + tid]; ks[tid] = QKml[tok * 512 + 256 + h * 64 + tid]; vs[tid] = bf2f(p[PCV + h * 64 + tid]); }
        if (tid == 64) { const float il = bf2f(p[PIG + h]) + ib[h]; const float z = bf2f(p[PFG + h]) + fb[h]; const float fl = fminf(z, 0.f) - log1pf(__expf(-fabsf(z)));
            gate[0] = __expf(fl); gate[1] = __expf(il); }
        __syncthreads();
        const float f = gate[0], ig = gate[1]; float po = 0.f; const float ve = vs[e];
#pragma unroll
        for (int j = 0; j < 16; ++j) { const int d = dq * 16 + j; C[j] = f * C[j] + ig * ks[d] * ve; po += qs[d] * C[j]; }
        part[dq][e] = po;
        if (tid < 64) { n = f * n + ig * ks[tid]; const float dn = wave_sum(qs[tid] * n); if (tid == 0) den_s[0] = dn; }
        __syncthreads();
        if (tid < 64) { const float num = part[0][tid] + part[1][tid] + part[2][tid] + part[3][tid]; const float hv = num / fmaxf(fabsf(den_s[0]), 1.f);
            const float r = rsqrtf(wave_sum(hv * hv) * (1.f / 64) + EPS); const int c = h * 64 + tid;
            BR[tok * 1024 + 512 + c] = (bf16)f2bf(sigmoidf_(bf2f(p[PCO + c])) * hv * r * onorm[c]); }
        __syncthreads();
    }
}
__global__ void k_s5_disc(const float* __restrict__ a_re, const float* __restrict__ a_im, const float* __restrict__ log_dt, const float* __restrict__ b_re, const float* __restrict__ b_im, float* __restrict__ disc) {
    const int i = blockIdx.x * blockDim.x + threadIdx.x; if (i >= 1024) return; const int g = i >> 6;
    const float dt = expf(log_dt[g]), ar = a_re[i], ai = a_im[i]; const float mag = expf(ar * dt); float sn, cs; sincosf(ai * dt, &sn, &cs);
    const float lr = mag * cs, li = mag * sn, inv = 1.f / (ar * ar + ai * ai);
    const float zr = ((lr - 1.f) * ar + li * ai) * inv, zi = (li * ar - (lr - 1.f) * ai) * inv;
    disc[i] = lr; disc[1024 + i] = li;
    for (int hh = 0; hh < 16; ++hh) { const float br = b_re[i * 16 + hh], bi = b_im[i * 16 + hh]; disc[2048 + i * 16 + hh] = zr * br - zi * bi; disc[2048 + 16384 + i * 16 + hh] = zr * bi + zi * br; }
}
__global__ void __launch_bounds__(64) k_s5_naive(const bf16* __restrict__ P, const float* __restrict__ disc, const float* __restrict__ c_re, const float* __restrict__ c_im, const float* __restrict__ dd, float* __restrict__ Yg) {
    const int g = blockIdx.x, b = blockIdx.y, p = threadIdx.x, i = g * 64 + p;
    const float lr = disc[i], li = disc[1024 + i]; float br[16], bi[16], cr[16], ci[16];
    for (int hh = 0; hh < 16; ++hh) { br[hh] = disc[2048 + i * 16 + hh]; bi[hh] = disc[2048 + 16384 + i * 16 + hh]; cr[hh] = c_re[(g * 16 + hh) * 64 + p]; ci[hh] = c_im[(g * 16 + hh) * 64 + p]; }
    float sr = 0.f, si = 0.f;
    for (int t = 0; t < T; ++t) { const size_t tok = (size_t)b * T + t; const bf16* pu = P + tok * NP + PDU + g * 16; float u[16]; float xr = 0.f, xi = 0.f;
#pragma unroll
        for (int hh = 0; hh < 16; ++hh) { u[hh] = bf2f(pu[hh]); xr += br[hh] * u[hh]; xi += bi[hh] * u[hh]; }
        const float nr = lr * sr - li * si + xr, ni = lr * si + li * sr + xi; sr = nr; si = ni;
        float mine = 0.f;
#pragma unroll
        for (int hh = 0; hh < 16; ++hh) { const float y = wave_sum(cr[hh] * sr - ci[hh] * si); if (p == hh) mine = y + dd[g * 16 + hh] * u[hh]; }
        if (p < 16) { const float x = mine; const float gl = 0.5f * x * (1.f + tanhf(0.7978845608028654f * (x + 0.044715f * x * x * x))); Yg[tok * 256 + g * 16 + p] = gl; }
    }
}
__global__ void __launch_bounds__(256) k_glu_naive(const float* __restrict__ Yg, const float* __restrict__ w, const float* __restrict__ bg, bf16* __restrict__ BR) {
    __shared__ float y[256]; const int tok = blockIdx.x, tid = threadIdx.x; y[tid] = Yg[(size_t)tok * 256 + tid]; __syncthreads();
    float z = bg[tid]; for (int k = 0; k < 256; ++k) z += y[k] * w[k * 256 + tid];
    BR[(size_t)tok * 1024 + 768 + tid] = (bf16)f2bf(y[tid] * sigmoidf_(z));
}
__global__ void __launch_bounds__(256) k_xa_naive(const bf16* __restrict__ Q, const bf16* __restrict__ Kx, const bf16* __restrict__ Vx, bf16* __restrict__ O) {
    __shared__ float qs[8][256], ps[8][256];
    const int qg = blockIdx.x, h = blockIdx.y, b = blockIdx.z, tid = threadIdx.x; const size_t tok0 = (size_t)b * T + qg * 8;
    for (int j = 0; j < 8; ++j) qs[j][tid] = bf2f(Q[(tok0 + j) * 1024 + h * 256 + tid]);
    __syncthreads();
    float s[8]; for (int j = 0; j < 8; ++j) s[j] = 0.f; const bf16* kr = Kx + ((size_t)b * MEM + tid) * 1024 + h * 256;
    for (int d = 0; d < 256; ++d) { const float kv = bf2f(kr[d]);
#pragma unroll
        for (int j = 0; j < 8; ++j) s[j] += qs[j][d] * kv; }
    for (int j = 0; j < 8; ++j) ps[j][tid] = s[j] * 0.0625f;
    __syncthreads();
    { const int w = tid >> 6, lane = tid & 63; for (int jj = 0; jj < 2; ++jj) { const int j = w * 2 + jj; float v[4]; float mx = -1e30f; for (int i = 0; i < 4; ++i) { v[i] = ps[j][lane + 64 * i]; mx = fmaxf(mx, v[i]); }
        mx = wave_max(mx); float sm = 0.f; for (int i = 0; i < 4; ++i) { v[i] = __expf(v[i] - mx); sm += v[i]; } sm = wave_sum(sm); const float inv = 1.f / sm; for (int i = 0; i < 4; ++i) ps[j][lane + 64 * i] = v[i] * inv; } }
    __syncthreads();
    float o[8]; for (int j = 0; j < 8; ++j) o[j] = 0.f;
    for (int m = 0; m < 256; ++m) { const float vv = bf2f(Vx[((size_t)b * MEM + m) * 1024 + h * 256 + tid]);
#pragma unroll
        for (int j = 0; j < 8; ++j) o[j] += ps[j][m] * vv; }
    for (int j = 0; j < 8; ++j) O[(tok0 + j) * 1024 + h * 256 + tid] = (bf16)f2bf(o[j]);
}
__global__ void k_lower_bounds(const float* __restrict__ logits, float* __restrict__ lb) {
    const int c = threadIdx.x; float v[DEPTH], mx = -1e30f; for (int l = 0; l < DEPTH; ++l) { v[l] = logits[l * 256 + c]; mx = fmaxf(mx, v[l]); }
    float s = 0.f; for (int l = 0; l < DEPTH; ++l) { v[l] = expf(v[l] - mx); s += v[l]; }
    float cum = 0.f; for (int l = 0; l < DEPTH; ++l) { cum += v[l] / s; lb[l * 256 + c] = cum - v[0] / s; }
}
constexpr size_t MiB = 1u << 20;
constexpr size_t WS_WT_IN = 1 * MiB, WS_WT_BR = 15 * MiB, WS_WT_OUT = 17 * MiB, WS_WT_XQ = 19 * MiB, WS_WT_XK = 21 * MiB, WS_WT_XV = 23 * MiB, WS_WT_XO = 25 * MiB, WS_WT_FI = 27 * MiB, WS_WT_FO = 39 * MiB;
constexpr size_t WS_LB = 45 * MiB, WS_DISC = 45 * MiB + 65536, WS_MEMN = 46 * MiB, WS_KX = 50 * MiB, WS_VX = 54 * MiB, WS_XN = 58 * MiB, WS_P = 90 * MiB;
constexpr size_t WS_Y = 90 * MiB, WS_QX = 154 * MiB, WS_OX = 186 * MiB, WS_H = 154 * MiB, WS_BR = 298 * MiB, WS_SCR = 330 * MiB;
constexpr size_t WS_QM = WS_SCR, WS_KVM = WS_SCR + 24 * MiB, WS_KR = WS_SCR + 56 * MiB, WS_QKML = WS_SCR, WS_YG = WS_SCR + 32 * MiB, WS_MG = WS_SCR, WS_END = 388 * MiB;
constexpr int GEMM_LDS = 131072;
template <class Epi> static void run_gemm(hipStream_t st, const bf16* A, int lda, const bf16* Bt, int ldb, int Mr, int N, int K, Epi E) {
    static bool attr = false;
    if (!attr) { (void)hipFuncSetAttribute((const void*)gemm_kernel<Epi>, hipFuncAttributeMaxDynamicSharedMemorySize, GEMM_LDS); attr = true; }
    pg8::Gemm g{}; g.A = A; g.Bt = Bt; g.M = Mr; g.N = N; g.K = K; g.lda = lda; g.ldb = ldb; g.pad = 0;
    hipLaunchKernelGGL(gemm_kernel<Epi>, dim3(256), dim3(512), GEMM_LDS, st, g, E);
}
static void conv_wt(hipStream_t st, const float* W, int K, int ldw, bf16* Wt, int N, int mode) {
    hipLaunchKernelGGL(k_convert_wt, dim3((N + 63) / 64, K / 64), dim3(256), 0, st, W, K, ldw, 0, Wt, N, mode);
}
extern "C" void kernel_launch(void* const* d_in, const int* in_sizes, int n_in, void* d_out, int out_size, void* d_ws, size_t ws_size, hipStream_t stream) {
    if (n_in != 42 || out_size != M * D || ws_size < WS_END) { fprintf(stderr, "kernel_launch: unexpected shapes (n_in %d out %d ws %zu)\n", n_in, out_size, ws_size); return; }
    const float* const* in = (const float* const*)d_in; unsigned char* ws = (unsigned char*)d_ws; float* x = (float*)d_out;
    const int* pos = (const int*)d_in[2];
    bf16 *WtIn = (bf16*)(ws + WS_WT_IN), *WtBr = (bf16*)(ws + WS_WT_BR), *WtOut = (bf16*)(ws + WS_WT_OUT), *WtXq = (bf16*)(ws + WS_WT_XQ), *WtXk = (bf16*)(ws + WS_WT_XK), *WtXv = (bf16*)(ws + WS_WT_XV),
         *WtXo = (bf16*)(ws + WS_WT_XO), *WtFi = (bf16*)(ws + WS_WT_FI), *WtFo = (bf16*)(ws + WS_WT_FO);
    float* LB = (float*)(ws + WS_LB); float* DISC = (float*)(ws + WS_DISC);
    bf16 *MEMN = (bf16*)(ws + WS_MEMN), *KX = (bf16*)(ws + WS_KX), *VX = (bf16*)(ws + WS_VX), *XN = (bf16*)(ws + WS_XN), *P = (bf16*)(ws + WS_P), *QX = (bf16*)(ws + WS_QX), *OX = (bf16*)(ws + WS_OX),
         *H = (bf16*)(ws + WS_H), *BR = (bf16*)(ws + WS_BR), *MG = (bf16*)(ws + WS_MG);
    float *Y = (float*)(ws + WS_Y), *QM = (float*)(ws + WS_QM), *KVM = (float*)(ws + WS_KVM), *KR = (float*)(ws + WS_KR), *QKML = (float*)(ws + WS_QKML), *YG = (float*)(ws + WS_YG);
    (void)hipMemcpyAsync(x, in[0], (size_t)M * D * 4, hipMemcpyDeviceToDevice, stream);
    hipLaunchKernelGGL(k_lower_bounds, dim3(1), dim3(256), 0, stream, in[10], LB);
    hipLaunchKernelGGL(k_rmsnorm_rows, dim3(M / 4), dim3(256), 0, stream, (const float*)x, in[3], XN, M);
    for (int l = 0; l < DEPTH; ++l) {
        conv_wt(stream, in[5] + (size_t)l * 1024 * N_IN, 1024, N_IN, WtIn, NP, 1);
        for (int n = 0; n < 4; ++n) conv_wt(stream, in[29] + ((size_t)l * 4 + n) * 256 * 1024, 256, 1024, WtBr + (size_t)n * 1024 * 256, 1024, 0);
        conv_wt(stream, in[30] + (size_t)l * 1024 * 1024, 1024, 1024, WtOut, 1024, 0);
        conv_wt(stream, in[34] + (size_t)l * 1024 * 1024, 1024, 1024, WtXq, 1024, 0);
        conv_wt(stream, in[35] + (size_t)l * 1024 * 1024, 1024, 1024, WtXk, 1024, 0);
        conv_wt(stream, in[36] + (size_t)l * 1024 * 1024, 1024, 1024, WtXv, 1024, 0);
        conv_wt(stream, in[37] + (size_t)l * 1024 * 1024, 1024, 1024, WtXo, 1024, 0);
        conv_wt(stream, in[40] + (size_t)l * 1024 * 2 * DFF, 1024, 2 * DFF, WtFi, 2 * DFF, 2);
        conv_wt(stream, in[41] + (size_t)l * DFF * 1024, DFF, 1024, WtFo, 1024, 0);
        hipLaunchKernelGGL(k_s5_disc, dim3(4), dim3(256), 0, stream, in[19] + l * 1024, in[20] + l * 1024, in[21] + l * 16, in[22] + l * 16384, in[23] + l * 16384, DISC);
        run_gemm(stream, XN, 1024, WtIn, 1024, M, NP, 1024, pg8::EpiStoreBf16{P, NP, 0});
        hipLaunchKernelGGL(k_mla_proj_naive, dim3(M), dim3(256), 0, stream, (const bf16*)P, pos, in[6] + l * 256, in[7] + (size_t)l * 256 * 384, in[8] + l * 128, in[9] + (size_t)l * 128 * 512, QM, KVM, KR);
        hipLaunchKernelGGL(k_mla_attn_naive, dim3(T / 64, 4, BATCH), dim3(64), 0, stream, (const float*)QM, (const float*)KVM, (const float*)KR, BR);
        hipLaunchKernelGGL(k_hgrn2_naive, dim3(4, BATCH), dim3(256), 0, stream, (const bf16*)P, (const float*)(LB + l * 256), in[11] + l * 256, BR);
        hipLaunchKernelGGL(k_ml_proj_naive, dim3(M), dim3(256), 0, stream, (const bf16*)P, in[12] + l * 1024, in[13] + l * 256, in[14] + (size_t)l * 16384, in[15] + (size_t)l * 16384, QKML);
        hipLaunchKernelGGL(k_mlstm_naive, dim3(4, BATCH), dim3(256), 0, stream, (const bf16*)P, (const float*)QKML, in[16] + l * 4, in[17] + l * 4, in[18] + l * 256, BR);
        hipLaunchKernelGGL(k_s5_naive, dim3(16, BATCH), dim3(64), 0, stream, (const bf16*)P, (const float*)DISC, in[24] + (size_t)l * 16384, in[25] + (size_t)l * 16384, in[26] + l * 256, YG);
        hipLaunchKernelGGL(k_glu_naive, dim3(M), dim3(256), 0, stream, (const float*)YG, in[27] + (size_t)l * 65536, in[28] + l * 256, BR);
        for (int n = 0; n < 4; ++n) run_gemm(stream, BR + 256 * n, 1024, WtBr + (size_t)n * 1024 * 256, 256, M, 1024, 256, pg8::EpiGate{MG, P + PG + 1024 * n, NP, n});
        run_gemm(stream, MG, 1024, WtOut, 1024, M, 1024, 1024, pg8::EpiStoreF32{Y, 1024, 0});
        hipLaunchKernelGGL(k_resid_norm, dim3(M / 4), dim3(256), 0, stream, x, (const float*)Y, in[4] + l * 1024, in[31] + l * 1024, XN);
        hipLaunchKernelGGL(k_rmsnorm_rows, dim3(MM / 4), dim3(256), 0, stream, in[1], in[33] + l * 1024, MEMN, MM);
        run_gemm(stream, MEMN, 1024, WtXk, 1024, MM, 1024, 1024, pg8::EpiStoreBf16{KX, 1024, 0});
        run_gemm(stream, MEMN, 1024, WtXv, 1024, MM, 1024, 1024, pg8::EpiStoreBf16{VX, 1024, 0});
        run_gemm(stream, XN, 1024, WtXq, 1024, M, 1024, 1024, pg8::EpiStoreBf16{QX, 1024, 0});
        hipLaunchKernelGGL(k_xa_naive, dim3(T / 8, 4, BATCH), dim3(256), 0, stream, (const bf16*)QX, (const bf16*)KX, (const bf16*)VX, OX);
        run_gemm(stream, OX, 1024, WtXo, 1024, M, 1024, 1024, pg8::EpiStoreF32{Y, 1024, 0});
        hipLaunchKernelGGL(k_resid_norm, dim3(M / 4), dim3(256), 0, stream, x, (const float*)Y, in[32] + l * 1024, in[38] + l * 1024, XN);
        run_gemm(stream, XN, 1024, WtFi, 1024, M, 2 * DFF, 1024, pg8::EpiSwiglu{H, DFF, 0});
        run_gemm(stream, H, DFF, WtFo, DFF, M, 1024, DFF, pg8::EpiStoreF32{Y, 1024, 0});
        hipLaunchKernelGGL(k_resid_norm, dim3(M / 4), dim3(256), 0, stream, x, (const float*)Y, in[39] + l * 1024, l + 1 < DEPTH ? in[3] + (l + 1) * 1024 : (const float*)nullptr, XN);
    }
}
```

```cpp
#include <hip/hip_runtime.h>
#include <cstdio>
#include <cstdint>
constexpr int BATCH = 8, T = 2048, D = 1024, DEPTH = 4, M = BATCH * T, MEM = 256, MM = BATCH * MEM;
constexpr int N_IN = 6568, NP = 6656, DFF = 2816;
constexpr float EPS = 1e-6f;
constexpr int PQ = 0, PKV = 256, PKR = 384, PIG = 416, PFG = 420, PBQ = 512, PBF = 768, PBI = 1024, PBG = 1280, PCX = 1536, PCV = 1792, PCO = 2048, PDU = 2304, PG = 2560;
typedef unsigned short bf16;
typedef unsigned v4u __attribute__((ext_vector_type(4)));
typedef unsigned v2u __attribute__((ext_vector_type(2)));
typedef float f32x4 __attribute__((ext_vector_type(4)));
typedef short bf16x8 __attribute__((ext_vector_type(8)));
#define LAS __attribute__((address_space(3)))
#define GAS __attribute__((address_space(1)))
__device__ __forceinline__ float bf2f(bf16 v) { return __uint_as_float(((unsigned)v) << 16); }
__device__ __forceinline__ unsigned f2bf(float f) { unsigned u = __float_as_uint(f); return (u + 0x7fffu + ((u >> 16) & 1u)) >> 16; }
__device__ __forceinline__ unsigned pk2(float lo, float hi) { return f2bf(lo) | (f2bf(hi) << 16); }
__device__ __forceinline__ float sigmoidf_(float x) { return 1.f / (1.f + __expf(-x)); }
__device__ __forceinline__ float siluf_(float x) { return x * sigmoidf_(x); }
__device__ __forceinline__ float wave_sum(float v) {
#pragma unroll
    for (int o = 1; o < 64; o <<= 1) v += __shfl_xor(v, o);
    return v;
}
__device__ __forceinline__ float wave_max(float v) {
#pragma unroll
    for (int o = 1; o < 64; o <<= 1) v = fmaxf(v, __shfl_xor(v, o));
    return v;
}
__host__ __device__ __forceinline__ int win_src(int n) {
    if (n < 416) return n;
    if (n < 420) return 2208 + (n - 416);
    if (n < 424) return 2212 + (n - 420);
    if (n < 512) return -1;
    if (n < 2304) return 416 + (n - 512);
    if (n < 2560) return 2216 + (n - 2304);
    return 2472 + (n - 2560);
}
__host__ __device__ __forceinline__ int ffn_src(int n) { const int t = n >> 8, w = n & 255; return w < 128 ? t * 128 + w : DFF + t * 128 + (w - 128); }
namespace pg8 {
#define PG8_LAS __attribute__((address_space(3)))
typedef unsigned short bf16_t;
typedef short bf16x8 __attribute__((ext_vector_type(8)));
typedef float f32x4 __attribute__((ext_vector_type(4)));
typedef unsigned u32x4 __attribute__((ext_vector_type(4)));
constexpr int BM = 256, BK = 64, HALF = 128, HTB = HALF * BK * 2  , STAGE_BYTES = 8 * HTB, NXCD = 8, WGM = 8;

__host__ __device__ __forceinline__ int lds_byte(int r, int c) { const int st = (r >> 4) * 2 + (c >> 5), rr = r & 15, cc = c & 31, ob = rr * 64 + cc * 2; return st * 1024 + (ob ^ (((ob >> 9) & 1) << 5)); }
__host__ __device__ __forceinline__ void stage_rc(int b, int& R, int& C) { const int st = b / 1024, sb = b % 1024, swz = sb ^ (((sb >> 9) & 1) << 5); R = (st >> 1) * 16 + swz / 64; C = (st & 1) * 32 + (swz % 64) / 2; }
__host__ __device__ __forceinline__ int perm32(int rho) { const int n = rho >> 4, i = rho & 15; return 8 * (i >> 2) + 4 * n + (i & 3); }

struct Unit { int pm, pn; long aoff, boff; };
struct Gemm { const bf16_t* A; const bf16_t* Bt; int M, N, K, lda, ldb, pad; };

struct StaticOrder {
    int nM, nN, nwg, G, c, lda, ldb;
    __host__ __device__ void init(const Gemm& g, int G_, int c_) { nM = g.M / BM; nN = g.N / BM; nwg = nM * nN; G = G_; c = c_; lda = g.lda; ldb = g.ldb; }
    __host__ __device__ bool next(int i, Unit& u) const {
        const long L = (long)i * G + c; if (L >= nwg) return false;
        int wgid = (int)L; { const int q = nwg / NXCD, r = nwg % NXCD, xcd = wgid % NXCD, off = wgid / NXCD; wgid = (xcd < r ? xcd * (q + 1) : r * (q + 1) + (xcd - r) * q) + off; }
        const int nig = WGM * nN, gid = wgid / nig, fm = gid * WGM, gsz = (nM - fm) < WGM ? (nM - fm) : WGM;
        u.pm = fm + ((wgid % nig) % gsz); u.pn = (wgid % nig) / gsz; u.aoff = (long)u.pm * BM * lda; u.boff = (long)u.pn * BM * ldb; return true;
    }
    __device__ __forceinline__ void a_ready(const Unit&) const {}
    __device__ __forceinline__ void done(const Unit&) const {}
};

__device__ __forceinline__ unsigned cvt_pk_bf16(float lo, float hi) { unsigned r; asm volatile("v_cvt_pk_bf16_f32 %0, %1, %2" : "=v"(r) : "v"(lo), "v"(hi)); return r; }
typedef float f32x2 __attribute__((ext_vector_type(2)));
template <class Epi, class Sched, bool ALIGN_EPI = false, bool SP2 = false>
__device__ __forceinline__ void gemm_phase(PG8_LAS unsigned char* lds, const Gemm g, const Sched& S, const Epi& E) {
    int tid_ = threadIdx.x; asm volatile("" : "+v"(tid_));
    const int tid = tid_, wid = __builtin_amdgcn_readfirstlane(tid >> 6), lane = tid & 63, wr = wid >> 2, wc = wid & 3, fr = lane & 15, fq = lane >> 4;
    const int K = g.K, nt = K / BK;
    unsigned voffA[2], voffB[2];
#pragma unroll
    for (int i = 0; i < 2; ++i) { int R, C; stage_rc(tid * 16 + i * 8192, R, C); const int Rb = Epi::PERM ? ((R & ~31) + perm32(R & 31)) : R;
        voffA[i] = (unsigned)(R * g.lda + C) * 2u; voffB[i] = (unsigned)(Rb * g.ldb + C) * 2u; }
    const size_t kstep = (size_t)(BK * 2);
    const size_t hstepA = (size_t)HALF * g.lda * 2, hstepB = (size_t)HALF * g.ldb * 2;
    const unsigned ldsw = (unsigned)wid * 1024u;
    const int aoff = lds_byte(wr * 64 + fr, fq * 8), boff = lds_byte(wc * 32 + fr, fq * 8);
#define PG8_SA(b, h) (((b) * 2 + (h)) * HTB)
#define PG8_SB(b, h) ((4 + (b) * 2 + (h)) * HTB)
#define PG8_STAGE(bufoff, gbase, voff) do { _Pragma("unroll") for (int _i = 0; _i < 2; ++_i) \
        __builtin_amdgcn_global_load_lds((const unsigned*)((const char*)(gbase) + (voff)[_i]), (PG8_LAS unsigned*)(lds + (bufoff) + ldsw + _i * 8192), 16, 0, 0); } while (0)
#define PG8_LDA(dst, b, h) do { _Pragma("unroll") for (int m = 0; m < 4; ++m) _Pragma("unroll") for (int k = 0; k < 2; ++k) dst[m][k] = *(const PG8_LAS bf16x8*)(lds + PG8_SA(b, h) + aoff + m * 2048 + k * 1024); } while (0)
#define PG8_LDB(dst, b, h) do { _Pragma("unroll") for (int n = 0; n < 2; ++n) _Pragma("unroll") for (int k = 0; k < 2; ++k) dst[n][k] = *(const PG8_LAS bf16x8*)(lds + PG8_SB(b, h) + boff + n * 2048 + k * 1024); } while (0)
#define PG8_MMA(ai, bj, At, Bt) do { __builtin_amdgcn_s_setprio(1); _Pragma("unroll") for (int m = 0; m < 4; ++m) _Pragma("unroll") for (int n = 0; n < 2; ++n) _Pragma("unroll") for (int k = 0; k < 2; ++k) \
        acc[ai][bj][m][n] = __builtin_amdgcn_mfma_f32_16x16x32_bf16(Bt[n][k], At[m][k], acc[ai][bj][m][n], 0, 0, 0); __builtin_amdgcn_s_setprio(0); } while (0)
#define PG8_WAIT_V(n) asm volatile("s_waitcnt vmcnt(" #n ")" ::: "memory")
#define PG8_WAIT_L(n) asm volatile("s_waitcnt lgkmcnt(" #n ")" ::: "memory")
#define PG8_BAR __builtin_amdgcn_s_barrier()
#define PG8_SCHED __builtin_amdgcn_sched_barrier(0)
    Unit cur, nxt; int ui = 0;
    if (!S.next(0, cur)) return;
    f32x4 acc[2][2][4][2];
#pragma unroll
    for (int a = 0; a < 2; ++a)
#pragma unroll
        for (int b = 0; b < 2; ++b)
#pragma unroll
            for (int m = 0; m < 4; ++m)
#pragma unroll
                for (int n = 0; n < 2; ++n) acc[a][b][m][n] = (f32x4){0.f, 0.f, 0.f, 0.f};
    bf16x8 At[4][2], B0[2][2], B1[2][2];
    const char* cA = (const char*)(g.A + cur.aoff); const char* cB = (const char*)(g.Bt + cur.boff);
    S.a_ready(cur);
    if constexpr (SP2) {
        PG8_STAGE(PG8_SB(0, 0), cB, voffB); PG8_STAGE(PG8_SB(0, 1), cB + hstepB, voffB); PG8_STAGE(PG8_SA(0, 0), cA, voffA); PG8_STAGE(PG8_SA(0, 1), cA + hstepA, voffA);
        if (wr == 1) PG8_BAR;
        PG8_WAIT_V(2); PG8_BAR;
        PG8_STAGE(PG8_SB(1, 0), cB + kstep, voffB); PG8_STAGE(PG8_SA(1, 0), cA + kstep, voffA); PG8_STAGE(PG8_SB(1, 1), cB + hstepB + kstep, voffB);
        PG8_WAIT_V(6); PG8_BAR;
    } else {
        PG8_STAGE(PG8_SB(0, 0), cB, voffB); PG8_STAGE(PG8_SA(0, 0), cA, voffA); PG8_STAGE(PG8_SB(0, 1), cB + hstepB, voffB); PG8_STAGE(PG8_SA(0, 1), cA + hstepA, voffA);
        if (wr == 1) PG8_BAR;
        PG8_WAIT_V(4); PG8_BAR;
        PG8_STAGE(PG8_SB(1, 0), cB + kstep, voffB); PG8_STAGE(PG8_SA(1, 0), cA + kstep, voffA); PG8_STAGE(PG8_SB(1, 1), cB + hstepB + kstep, voffB);
        PG8_WAIT_V(6); PG8_BAR;
    }
    for (;;) {
        const bool has_next = S.next(ui + 1, nxt);
        const char* nA = has_next ? (const char*)(g.A + nxt.aoff) : cA; const char* nB = has_next ? (const char*)(g.Bt + nxt.boff) : cB;
        for (int t = 0; t < nt; t += 2) {
            const bool last = (t == nt - 2);
            const char* a1 = cA + (size_t)(t + 1) * kstep;
            const char* a2 = last ? nA : cA + (size_t)(t + 2) * kstep; const char* b2 = last ? nB : cB + (size_t)(t + 2) * kstep;
            const char* a3 = a2 + kstep; const char* b3 = b2 + kstep;
            if (last && has_next) S.a_ready(nxt);
            if constexpr (SP2) {
            PG8_LDB(B0, 0, 0); PG8_LDB(B1, 0, 1); PG8_SCHED; PG8_LDA(At, 0, 0); PG8_STAGE(PG8_SA(1, 1), a1 + hstepA, voffA);
            PG8_WAIT_V(8); PG8_WAIT_L(0); PG8_BAR; PG8_MMA(0, 0, At, B0); PG8_MMA(0, 1, At, B1); PG8_BAR; PG8_SCHED;
            PG8_LDA(At, 0, 1); PG8_STAGE(PG8_SB(0, 0), b2, voffB); PG8_STAGE(PG8_SB(0, 1), b2 + hstepB, voffB); PG8_STAGE(PG8_SA(0, 0), a2, voffA);
            PG8_WAIT_V(8); PG8_WAIT_L(0); PG8_BAR; PG8_MMA(1, 0, At, B0); PG8_MMA(1, 1, At, B1); PG8_BAR; PG8_SCHED;
            PG8_LDB(B0, 1, 0); PG8_LDB(B1, 1, 1); PG8_SCHED; PG8_LDA(At, 1, 0); PG8_STAGE(PG8_SA(0, 1), a2 + hstepA, voffA);
            PG8_WAIT_V(8); PG8_WAIT_L(0); PG8_BAR; PG8_MMA(0, 0, At, B0); PG8_MMA(0, 1, At, B1); PG8_BAR; PG8_SCHED;
            PG8_LDA(At, 1, 1); PG8_STAGE(PG8_SB(1, 0), b3, voffB); PG8_STAGE(PG8_SB(1, 1), b3 + hstepB, voffB); PG8_STAGE(PG8_SA(1, 0), a3, voffA);
            PG8_WAIT_V(8); PG8_WAIT_L(0); PG8_BAR; PG8_MMA(1, 0, At, B0); PG8_MMA(1, 1, At, B1); PG8_BAR; PG8_SCHED;
            } else {
            PG8_LDB(B0, 0, 0); PG8_SCHED; PG8_LDA(At, 0, 0); PG8_STAGE(PG8_SA(1, 1), a1 + hstepA, voffA);
            PG8_WAIT_L(8); PG8_BAR; PG8_WAIT_L(0); PG8_MMA(0, 0, At, B0); PG8_BAR; PG8_SCHED;
            PG8_LDB(B1, 0, 1); PG8_STAGE(PG8_SB(0, 0), b2, voffB);
            PG8_BAR; PG8_WAIT_L(0); PG8_MMA(0, 1, At, B1); PG8_BAR;
            PG8_LDA(At, 0, 1); PG8_STAGE(PG8_SA(0, 0), a2, voffA);
            PG8_BAR; PG8_WAIT_L(0); PG8_MMA(1, 0, At, B0); PG8_BAR; PG8_SCHED;
            PG8_STAGE(PG8_SB(0, 1), b2 + hstepB, voffB);
            PG8_WAIT_V(6); PG8_BAR; PG8_MMA(1, 1, At, B1); PG8_BAR;
            PG8_LDB(B0, 1, 0); PG8_SCHED; PG8_LDA(At, 1, 0); PG8_STAGE(PG8_SA(0, 1), a2 + hstepA, voffA);
            PG8_WAIT_L(8); PG8_BAR; PG8_WAIT_L(0); PG8_MMA(0, 0, At, B0); PG8_BAR; PG8_SCHED;
            PG8_LDB(B1, 1, 1); PG8_STAGE(PG8_SB(1, 0), b3, voffB);
            PG8_BAR; PG8_WAIT_L(0); PG8_MMA(0, 1, At, B1); PG8_BAR;
            PG8_LDA(At, 1, 1); PG8_STAGE(PG8_SA(1, 0), a3, voffA);
            PG8_BAR; PG8_WAIT_L(0); PG8_MMA(1, 0, At, B0); PG8_BAR; PG8_SCHED;
            PG8_STAGE(PG8_SB(1, 1), b3 + hstepB, voffB);
            PG8_WAIT_V(6); PG8_BAR; PG8_MMA(1, 1, At, B1); PG8_BAR;
            }
        }
        if constexpr (ALIGN_EPI) { if (wr == 0) PG8_BAR; }
        if constexpr (!Epi::AFTER_DRAIN) { E(acc, cur, wr, wc, fr, fq); S.done(cur); }
        if (!has_next) break;
#pragma unroll
        for (int a = 0; a < 2; ++a)
#pragma unroll
            for (int b = 0; b < 2; ++b)
#pragma unroll
                for (int m = 0; m < 4; ++m)
#pragma unroll
                    for (int n = 0; n < 2; ++n) acc[a][b][m][n] = (f32x4){0.f, 0.f, 0.f, 0.f};
        cur = nxt; cA = nA; cB = nB; ++ui;
        if constexpr (ALIGN_EPI) { if (wr == 1) PG8_BAR; }
    }
    PG8_WAIT_V(0);
    if constexpr (!ALIGN_EPI) { if (wr == 0) PG8_BAR; }
    PG8_BAR;
    if constexpr (Epi::AFTER_DRAIN) { E.fused(acc, cur, wr, wc, fr, fq, lds, wid, lane); S.done(cur); }
#undef PG8_SA
#undef PG8_SB
#undef PG8_STAGE
#undef PG8_LDA
#undef PG8_LDB
#undef PG8_MMA
#undef PG8_WAIT_V
#undef PG8_WAIT_L
#undef PG8_BAR
#undef PG8_SCHED
}
}
namespace pg8 {
struct EpiStoreBf16 {
    static constexpr bool PERM = true, AFTER_DRAIN = false;
    bf16_t* O; int ldc; float scale;
    __device__ __forceinline__ void operator()(const f32x4 (&acc)[2][2][4][2], const Unit& u, int wr, int wc, int fr, int fq) const {
        const int row0 = u.pm * BM + wr * 64 + fr, col0 = u.pn * BM + wc * 32 + 8 * fq;
#pragma unroll
        for (int ai = 0; ai < 2; ++ai)
#pragma unroll
            for (int m = 0; m < 4; ++m) { bf16_t* rowp = O + (size_t)(row0 + ai * HALF + m * 16) * ldc + col0;
#pragma unroll
                for (int bj = 0; bj < 2; ++bj) { const f32x4 v0 = acc[ai][bj][m][0] * scale, v1 = acc[ai][bj][m][1] * scale;
                    u32x4 w; w.x = cvt_pk_bf16(v0[0], v0[1]); w.y = cvt_pk_bf16(v0[2], v0[3]); w.z = cvt_pk_bf16(v1[0], v1[1]); w.w = cvt_pk_bf16(v1[2], v1[3]);
                    *(u32x4*)(rowp + bj * HALF) = w; } }
    }
};
struct EpiStoreF32 {
    static constexpr bool PERM = false, AFTER_DRAIN = false;
    float* O; int ldc;
    __device__ __forceinline__ void operator()(const f32x4 (&acc)[2][2][4][2], const Unit& u, int wr, int wc, int fr, int fq) const {
        const int row0 = u.pm * BM + wr * 64 + fr, col0 = u.pn * BM + wc * 32 + 4 * fq;
#pragma unroll
        for (int ai = 0; ai < 2; ++ai)
#pragma unroll
            for (int m = 0; m < 4; ++m) { float* rowp = O + (size_t)(row0 + ai * HALF + m * 16) * ldc + col0;
#pragma unroll
                for (int bj = 0; bj < 2; ++bj)
#pragma unroll
                    for (int n = 0; n < 2; ++n) *(f32x4*)(rowp + bj * HALF + n * 16) = acc[ai][bj][m][n]; }
    }
};
struct EpiSwiglu {
    static constexpr bool PERM = true, AFTER_DRAIN = false;
    bf16_t* O; int ldc;
    __device__ __forceinline__ void operator()(const f32x4 (&acc)[2][2][4][2], const Unit& u, int wr, int wc, int fr, int fq) const {
        const int row0 = u.pm * BM + wr * 64 + fr, col0 = u.pn * HALF + wc * 32 + 8 * fq;
#pragma unroll
        for (int ai = 0; ai < 2; ++ai)
#pragma unroll
            for (int m = 0; m < 4; ++m) { bf16_t* rowp = O + (size_t)(row0 + ai * HALF + m * 16) * ldc + col0;
                float h[8];
#pragma unroll
                for (int n = 0; n < 2; ++n)
#pragma unroll
                    for (int i = 0; i < 4; ++i) { const float a = acc[ai][0][m][n][i], b = acc[ai][1][m][n][i]; h[n * 4 + i] = a / (1.f + __expf(-a)) * b; }
                u32x4 w; w.x = cvt_pk_bf16(h[0], h[1]); w.y = cvt_pk_bf16(h[2], h[3]); w.z = cvt_pk_bf16(h[4], h[5]); w.w = cvt_pk_bf16(h[6], h[7]);
                *(u32x4*)rowp = w; }
    }
};
struct EpiGate {
    static constexpr bool PERM = false, AFTER_DRAIN = false;
    bf16_t* O; const bf16_t* G; int ldg; int br;
    __device__ __forceinline__ void operator()(const f32x4 (&acc)[2][2][4][2], const Unit& u, int wr, int wc, int fr, int fq) const {
        const int row0 = u.pm * BM + wr * 64 + fr, col0 = u.pn * BM + wc * 32 + 4 * fq;
#pragma unroll
        for (int ai = 0; ai < 2; ++ai)
#pragma unroll
            for (int m = 0; m < 4; ++m) { const size_t row = (size_t)(row0 + ai * HALF + m * 16);
#pragma unroll
                for (int bj = 0; bj < 2; ++bj)
#pragma unroll
                    for (int n = 0; n < 2; ++n) { const int col = col0 + bj * HALF + n * 16;
                        const unsigned long long gw = *(const unsigned long long*)(G + row * ldg + col);
                        f32x4 o = acc[ai][bj][m][n];
#pragma unroll
                        for (int i = 0; i < 4; ++i) { const float g = __uint_as_float((unsigned)((gw >> (16 * i)) & 0xffffull) << 16); o[i] = o[i] / (1.f + __expf(-g)); }
                        unsigned long long* op = (unsigned long long*)(O + row * 1024 + col);
                        if (br > 0) { const unsigned long long pw = *op;
#pragma unroll
                            for (int i = 0; i < 4; ++i) o[i] += __uint_as_float((unsigned)((pw >> (16 * i)) & 0xffffull) << 16); }
                        *op = (unsigned long long)cvt_pk_bf16(o[0], o[1]) | ((unsigned long long)cvt_pk_bf16(o[2], o[3]) << 32); }
            }
    }
};
struct EpiSoftmax {
    static constexpr bool PERM = true, AFTER_DRAIN = false;
    bf16_t* O; int ldc; PG8_LAS float* X;
    __device__ __forceinline__ void operator()(f32x4 (&acc)[2][2][4][2], const Unit& u, int wr, int wc, int fr, int fq) const {
#pragma unroll
        for (int ai = 0; ai < 2; ++ai)
#pragma unroll
            for (int m = 0; m < 4; ++m) { float rs = 0.f;
#pragma unroll
                for (int bj = 0; bj < 2; ++bj)
#pragma unroll
                    for (int n = 0; n < 2; ++n) { f32x4 e = acc[ai][bj][m][n];
#pragma unroll
                        for (int i = 0; i < 4; ++i) { e[i] = __expf(fminf(e[i], 80.f)); rs += e[i]; } acc[ai][bj][m][n] = e; }
                rs += __shfl_xor(rs, 16); rs += __shfl_xor(rs, 32);
                if (fq == 0) X[(ai * HALF + wr * 64 + m * 16 + fr) * 4 + wc] = rs; }
        asm volatile("s_waitcnt lgkmcnt(0)" ::: "memory"); __builtin_amdgcn_s_barrier(); asm volatile("" ::: "memory");
        const int row0 = u.pm * BM + wr * 64 + fr, col0 = u.pn * BM + wc * 32 + 8 * fq;
#pragma unroll
        for (int ai = 0; ai < 2; ++ai)
#pragma unroll
            for (int m = 0; m < 4; ++m) { const f32x4 p4 = *(const PG8_LAS f32x4*)(X + (ai * HALF + wr * 64 + m * 16 + fr) * 4); const float inv = 1.f / ((p4[0] + p4[1]) + (p4[2] + p4[3]));
                bf16_t* rowp = O + (size_t)(row0 + ai * HALF + m * 16) * ldc + col0;
#pragma unroll
                for (int bj = 0; bj < 2; ++bj) { const f32x4 v0 = acc[ai][bj][m][0] * inv, v1 = acc[ai][bj][m][1] * inv;
                    u32x4 w; w.x = cvt_pk_bf16(v0[0], v0[1]); w.y = cvt_pk_bf16(v0[2], v0[3]); w.z = cvt_pk_bf16(v1[0], v1[1]); w.w = cvt_pk_bf16(v1[2], v1[3]);
                    *(u32x4*)(rowp + bj * HALF) = w; } }
        asm volatile("s_waitcnt lgkmcnt(0)" ::: "memory"); __builtin_amdgcn_s_barrier(); asm volatile("" ::: "memory");
    }
};
struct BatchedOrder {
    int G, c, lda, ldb;
    __device__ bool next(int i, Unit& u) const { const long L = (long)i * G + c; if (L >= 256) return false; const int b = (int)L & 7, r = (int)L >> 3, pml = r & 7, pn = r >> 3;
        u.pm = b * 8 + pml; u.pn = pn; u.aoff = (long)u.pm * BM * lda; u.boff = (long)(b * 4 + pn) * BM * ldb; return true; }
    __device__ __forceinline__ void a_ready(const Unit&) const {}
    __device__ __forceinline__ void done(const Unit&) const {}
};
struct WeOrder {
    int c;
    __device__ bool next(int i, Unit& u) const { if (i > 0 || c >= 128) return false; const int b = c & 7, r = c >> 3, h = r & 3, pn = r >> 2;
        u.pm = b * 4 + h; u.pn = pn; u.aoff = (long)(b * 256) * 2048 + h * 256; u.boff = (long)(pn * 256) * 1024 + h * 256; return true; }
    __device__ __forceinline__ void a_ready(const Unit&) const {}
    __device__ __forceinline__ void done(const Unit&) const {}
};
struct VwOrder {
    int c;
    __device__ bool next(int i, Unit& u) const { if (i > 0 || c < 128 || c >= 256) return false; const int L = c - 128, b = L & 7, r = L >> 3, h = r & 3, ot = r >> 2;
        u.pm = b * 4 + ot; u.pn = h; u.aoff = (long)(ot * 256) * 1024 + h * 256; u.boff = (long)(b * 256) * 2048 + 1024 + h * 256; return true; }
    __device__ __forceinline__ void a_ready(const Unit&) const {}
    __device__ __forceinline__ void done(const Unit&) const {}
};
}
#define XB_TMO      128
#define XB_XCNT(j)  (256  + 64 * (j))
#define XB_XSUB(j)  (1280 + 64 * (j))
#define XB_XGEN(j)  (2304 + 64 * (j))
#define XB_TOP      3328
#define XB_TOPGEN   3392
#define XCD_BAR_WORDS 3456
#define XB_SPIN_CAP (1u << 18)

__device__ __forceinline__ unsigned xb_ld(unsigned* p)              { return __hip_atomic_load(p, __ATOMIC_RELAXED, __HIP_MEMORY_SCOPE_AGENT); }
__device__ __forceinline__ unsigned xb_add(unsigned* p, unsigned v) { return __hip_atomic_fetch_add(p, v, __ATOMIC_RELAXED, __HIP_MEMORY_SCOPE_AGENT); }
__device__ __forceinline__ unsigned xb_xcc_id() { return (unsigned)__builtin_amdgcn_s_getreg((3 << 11) | 20) & 0xFu; }
#define XB_SPIN(cond, bar) do { unsigned _sp = 0; while (cond) { __builtin_amdgcn_s_sleep(1); \
    if ((++_sp & 255u) == 0u) { if (xb_ld(&(bar)[XB_TMO])) break; if (_sp > XB_SPIN_CAP) { atomicAdd(&(bar)[XB_TMO], 1u); break; } } } } while (0)

struct XcdBarrier {
    unsigned* bar; unsigned x;
    volatile LAS unsigned* st;
};

__device__ __forceinline__ XcdBarrier xcd_barrier_post(unsigned* bar, volatile LAS unsigned* st) {
    XcdBarrier b; b.bar = bar; b.x = xb_xcc_id(); b.st = st;
    if (threadIdx.x == 0) (void)xb_add(&bar[XB_XCNT(b.x)], 1u);
    return b;
}
__device__ __forceinline__ void xcd_barrier_complete(unsigned* bar, unsigned x, unsigned& nloc, unsigned& nx) {
    const unsigned G = gridDim.x * gridDim.y * gridDim.z;
    unsigned sum, cnt, mine, sp = 0u;
    for (;;) {
        sum = 0u; cnt = 0u; mine = 0u;
#pragma unroll
        for (unsigned j = 0; j < 16; ++j) { const unsigned c = xb_ld(&bar[XB_XCNT(j)]); sum += c; cnt += (c > 0u) ? 1u : 0u; mine = (j == x) ? c : mine; }
        if (sum == G) break;
        __builtin_amdgcn_s_sleep(1);
        if ((++sp & 255u) == 0u) { if (xb_ld(&bar[XB_TMO])) break; if (sp > XB_SPIN_CAP) { atomicAdd(&bar[XB_TMO], 1u); break; } }
    }
    nloc = mine > 0u ? mine : 1u; nx = cnt > 0u ? cnt : 1u;
}

__device__ __forceinline__ void xcd_barrier(const XcdBarrier& b) {
    asm volatile("s_waitcnt vmcnt(0)" ::: "memory");
    __syncthreads();
    if (threadIdx.x == 0) {
        unsigned zoff = 0; asm volatile("" : "+s"(zoff));
        unsigned* bar = b.bar + zoff;
        __builtin_amdgcn_s_waitcnt(0);
        unsigned nloc = b.st[0], nx = b.st[1];
        if (nloc == 0u) { xcd_barrier_complete(bar, b.x, nloc, nx); b.st[0] = nloc; b.st[1] = nx; }
        const unsigned old = xb_add(&bar[XB_XSUB(b.x)], 1u);
        const unsigned gen = old / nloc;
        if (old + 1u == (gen + 1u) * nloc) {
            __builtin_amdgcn_fence(__ATOMIC_RELEASE, "agent");
            asm volatile("s_waitcnt vmcnt(0)" ::: "memory");
            const unsigned og = xb_add(&bar[XB_TOP], 1u);
            const unsigned tg = og / nx;
            if (og + 1u == (tg + 1u) * nx) xb_add(&bar[XB_TOPGEN], 1u);
            else XB_SPIN(xb_ld(&bar[XB_TOPGEN]) == tg, bar);
            __builtin_amdgcn_fence(__ATOMIC_ACQUIRE, "agent");
            xb_add(&bar[XB_XGEN(b.x)], 1u);
            asm volatile("s_waitcnt vmcnt(0)" ::: "memory");
        } else {
            XB_SPIN(xb_ld(&bar[XB_XGEN(b.x)]) == gen, bar);
            __builtin_amdgcn_fence(__ATOMIC_ACQUIRE, "agent");
            asm volatile("s_waitcnt vmcnt(0)" ::: "memory");
        }
    }
    __syncthreads();
}
constexpr size_t MiB = 1u << 20;
constexpr size_t WS_CTL = 0, CTL_ZERO_BYTES = 65536;
constexpr size_t WS_WT_IN = 1 * MiB, WS_WT_BR = 14 * MiB, WS_WT_OUT = 16 * MiB, WS_WQ = 18 * MiB, WS_WT_XKV = 20 * MiB, WS_WT_XO = 24 * MiB, WS_WT_FI = 26 * MiB, WS_WT_FO = 37 * MiB;
constexpr size_t WS_WT_UQ = 43 * MiB, WS_WT_UKV = WS_WT_UQ + 196608, WS_WT_MLQ = WS_WT_UKV + 131072, WS_WT_MLK = WS_WT_MLQ + 32768, WS_WT_GLU = WS_WT_MLK + 32768;
constexpr size_t WS_LB = 44 * MiB, WS_DISC = 44 * MiB + 65536;
constexpr size_t WS_CC = 44 * MiB + 524288, WS_S5E = 361 * MiB;
constexpr size_t WS_KVH = 363 * MiB, WS_DEC = 371 * MiB, WS_BREF = 371 * MiB + 262144;
constexpr size_t WS_CH = 329 * MiB, WS_QML = 337 * MiB, WS_KML = 345 * MiB, WS_NEND = 353 * MiB, WS_DECM = 353 * MiB + 262144;
constexpr size_t WS_MEMN = 45 * MiB, WS_KVX = 49 * MiB, WS_WET = 57 * MiB, WS_VWT = 73 * MiB, WS_XN = 89 * MiB, WS_P = 121 * MiB;
constexpr size_t WS_Y = WS_P, WS_PR = WS_P + 64 * MiB, WS_H = WS_P + 64 * MiB;
constexpr size_t WS_BR = WS_XN, WS_SCR = 329 * MiB;
constexpr size_t WS_QM = WS_SCR, WS_KVM = WS_SCR + 24 * MiB, WS_KR = WS_SCR + 56 * MiB, WS_QKML = WS_SCR, WS_YG = WS_SCR + 32 * MiB;
constexpr size_t WS_MG = WS_SCR;
constexpr size_t WS_QMB = 377 * MiB, WS_KMB = 389 * MiB, WS_VT = 401 * MiB;
constexpr size_t WS_END = 409 * MiB;
constexpr int RING_BYTES = 131072, XCH_OFF = 131072, LDSCTL_OFF = 135168, MISC_OFF = LDSCTL_OFF + 320, LDS_BYTES = 147456;
constexpr int NWAVES = 8, NPH = 14, N_PHASES = DEPTH * NPH;
constexpr int CW_TMO = 0, CW_BAR = 4096;
typedef GAS unsigned gu32;
#define RLX_AGENT __ATOMIC_RELAXED, __HIP_MEMORY_SCOPE_AGENT
#define LDS_WAIT() asm volatile("s_waitcnt lgkmcnt(0)" ::: "memory")
#define VM_WAIT() asm volatile("s_waitcnt vmcnt(0)" ::: "memory")
struct Args { const float* in[42]; float* out; unsigned char* ws; int ph_lo, ph_hi; };
__device__ __forceinline__ const float* inp(const Args& a, int k) { asm volatile("" : "+s"(k)); return a.in[k]; }
__device__ __forceinline__ unsigned char* wsp(const Args& a) { unsigned z = 0; asm volatile("" : "+s"(z)); return a.ws + z; }
struct Frame {
    LAS unsigned char* lds; int tid, lane, wave, G, gw, NGW;
};
template <int MODE> __device__ __forceinline__ void tr_item(const float* __restrict__ W, int ldw, int Kd, int N, bf16* __restrict__ WT, LAS float* scr, int item, int lane) {
    const int nblk = N / 32, kb = item / nblk, nb = item % nblk, k0 = 64 * kb, n0 = 32 * nb;
    const int n = n0 + (lane & 31); const int src = MODE == 0 ? n : (MODE == 1 ? win_src(n) : ffn_src(n));
#pragma unroll 8
    for (int i = 0; i < 32; ++i) { const int kk = 2 * i + (lane >> 5); scr[kk * 33 + (lane & 31)] = src >= 0 ? W[(size_t)(k0 + kk) * ldw + src] : 0.f; }
    LDS_WAIT(); asm volatile("" ::: "memory");
    const int c = lane & 7;
#pragma unroll
    for (int j = 0; j < 4; ++j) { const int nn = (lane >> 3) + 8 * j; const LAS float* s = scr + (8 * c) * 33 + nn;
        v4u o; o.x = pk2(s[0 * 33], s[1 * 33]); o.y = pk2(s[2 * 33], s[3 * 33]); o.z = pk2(s[4 * 33], s[5 * 33]); o.w = pk2(s[6 * 33], s[7 * 33]);
        *(GAS v4u*)(WT + (size_t)(n0 + nn) * Kd + k0 + 8 * c) = o; }
    LDS_WAIT(); asm volatile("" ::: "memory");
}
__device__ __forceinline__ void rms_row_to_bf16(const float* __restrict__ xrow, const float* __restrict__ g, bf16* __restrict__ orow, float* __restrict__ copy, int lane) {
    const f32x4* xr = (const f32x4*)xrow + lane; f32x4 v[4]; float s = 0.f;
#pragma unroll
    for (int j = 0; j < 4; ++j) { v[j] = xr[64 * j]; s += v[j].x * v[j].x + v[j].y * v[j].y + v[j].z * v[j].z + v[j].w * v[j].w; }
    if (copy) {
#pragma unroll
        for (int j = 0; j < 4; ++j) ((f32x4*)copy)[lane + 64 * j] = v[j]; }
    const float rstd = rsqrtf(wave_sum(s) * (1.f / D) + EPS); v2u* o = (v2u*)orow + lane;
#pragma unroll
    for (int j = 0; j < 4; ++j) { const f32x4 gg = ((const f32x4*)g)[lane + 64 * j]; v2u w; w.x = pk2(v[j].x * rstd * gg.x, v[j].y * rstd * gg.y); w.y = pk2(v[j].z * rstd * gg.z, v[j].w * rstd * gg.w); o[64 * j] = w; }
}
__device__ __forceinline__ void resid_norm_row(float* __restrict__ xrow, const float* __restrict__ yrow, const float* __restrict__ g1, const float* __restrict__ g2, bf16* __restrict__ xnrow, int lane) {
    const f32x4* yr = (const f32x4*)yrow + lane; f32x4* xr = (f32x4*)xrow + lane; f32x4 v[4], xv[4]; float s = 0.f;
#pragma unroll
    for (int j = 0; j < 4; ++j) { v[j] = yr[64 * j]; s += v[j].x * v[j].x + v[j].y * v[j].y + v[j].z * v[j].z + v[j].w * v[j].w; }
    const float rstd = rsqrtf(wave_sum(s) * (1.f / D) + EPS); float s2 = 0.f;
#pragma unroll
    for (int j = 0; j < 4; ++j) { const f32x4 gg = ((const f32x4*)g1)[lane + 64 * j]; xv[j] = xr[64 * j] + v[j] * rstd * gg; xr[64 * j] = xv[j];
        s2 += xv[j].x * xv[j].x + xv[j].y * xv[j].y + xv[j].z * xv[j].z + xv[j].w * xv[j].w; }
    if (g2) { const float r2 = rsqrtf(wave_sum(s2) * (1.f / D) + EPS); v2u* o = (v2u*)xnrow + lane;
#pragma unroll
        for (int j = 0; j < 4; ++j) { const f32x4 gg = ((const f32x4*)g2)[lane + 64 * j]; v2u w; w.x = pk2(xv[j].x * r2 * gg.x, xv[j].y * r2 * gg.y); w.y = pk2(xv[j].z * r2 * gg.z, xv[j].w * r2 * gg.w); o[64 * j] = w; } }
}
__device__ __forceinline__ void phase_prep(const Frame& F_, const Args& a, int l) {
    Frame F = F_; asm volatile("" : "+v"(F.tid), "+v"(F.lane)); asm volatile("" : "+s"(l));
    unsigned char* ws = wsp(a); LAS float* scr = (LAS float*)(F.lds + F.wave * 16384);
    constexpr int I_IN = 16 * 208, I_SQ = 512, I_BR = 512, I_FI = 16 * 176, I_FO = 44 * 32, I_UQ = 48, I_UKV = 32, I_ML = 8, I_GLU = 32;
    constexpr int NIT = I_IN + I_BR + 4 * I_SQ + I_FI + I_FO + I_UQ + I_UKV + 2 * I_ML + I_GLU;
    for (int it = F.gw; it < NIT; it += F.NGW) { int r = it;
        if (r < I_IN) { tr_item<1>(inp(a, 5) + (size_t)l * 1024 * N_IN, N_IN, 1024, NP, (bf16*)(ws + WS_WT_IN), scr, r, F.lane); continue; } r -= I_IN;
        if (r < I_BR) { const int n = r >> 7; tr_item<0>(inp(a, 29) + ((size_t)l * 4 + n) * 256 * 1024, 1024, 256, 1024, (bf16*)(ws + WS_WT_BR) + (size_t)n * 1024 * 256, scr, r & 127, F.lane); continue; } r -= I_BR;
        if (r < I_SQ) { tr_item<0>(inp(a, 30) + (size_t)l * 1048576, 1024, 1024, 1024, (bf16*)(ws + WS_WT_OUT), scr, r, F.lane); continue; } r -= I_SQ;
        if (r < I_SQ) { tr_item<0>(inp(a, 35) + (size_t)l * 1048576, 1024, 1024, 1024, (bf16*)(ws + WS_WT_XKV), scr, r, F.lane); continue; } r -= I_SQ;
        if (r < I_SQ) { tr_item<0>(inp(a, 36) + (size_t)l * 1048576, 1024, 1024, 1024, (bf16*)(ws + WS_WT_XKV) + 1048576, scr, r, F.lane); continue; } r -= I_SQ;
        if (r < I_SQ) { tr_item<0>(inp(a, 37) + (size_t)l * 1048576, 1024, 1024, 1024, (bf16*)(ws + WS_WT_XO), scr, r, F.lane); continue; } r -= I_SQ;
        if (r < I_FI) { tr_item<2>(inp(a, 40) + (size_t)l * 1024 * 2 * DFF, 2 * DFF, 1024, 2 * DFF, (bf16*)(ws + WS_WT_FI), scr, r, F.lane); continue; } r -= I_FI;
        if (r < I_FO) { tr_item<0>(inp(a, 41) + (size_t)l * DFF * 1024, 1024, DFF, 1024, (bf16*)(ws + WS_WT_FO), scr, r, F.lane); continue; } r -= I_FO;
        if (r < I_UQ) { tr_item<0>(inp(a, 7) + (size_t)l * 256 * 384, 384, 256, 384, (bf16*)(ws + WS_WT_UQ), scr, r, F.lane); continue; } r -= I_UQ;
        if (r < I_UKV) { tr_item<0>(inp(a, 9) + (size_t)l * 128 * 512, 512, 128, 512, (bf16*)(ws + WS_WT_UKV), scr, r, F.lane); continue; } r -= I_UKV;
        if (r < I_ML) { const int h = r >> 1; tr_item<0>(inp(a, 14) + ((size_t)l * 4 + h) * 4096, 64, 64, 64, (bf16*)(ws + WS_WT_MLQ) + h * 4096, scr, r & 1, F.lane); continue; } r -= I_ML;
        if (r < I_ML) { const int h = r >> 1; tr_item<0>(inp(a, 15) + ((size_t)l * 4 + h) * 4096, 64, 64, 64, (bf16*)(ws + WS_WT_MLK) + h * 4096, scr, r & 1, F.lane); continue; } r -= I_ML;
        tr_item<0>(inp(a, 27) + (size_t)l * 65536, 256, 256, 256, (bf16*)(ws + WS_WT_GLU), scr, r, F.lane);
    }
    { const f32x4* src = (const f32x4*)(inp(a, 34) + (size_t)l * 1048576); v2u* dst = (v2u*)(ws + WS_WQ);
      for (int i = F.gw * 64 + F.lane; i < 262144; i += F.NGW * 64) { const f32x4 v = src[i]; v2u w; w.x = pk2(v.x, v.y); w.y = pk2(v.z, v.w); dst[i] = w; } }
    for (int m = F.gw; m < MM; m += F.NGW) rms_row_to_bf16(inp(a, 1) + (size_t)m * D, inp(a, 33) + l * 1024, (bf16*)(ws + WS_MEMN) + (size_t)m * D, nullptr, F.lane);
    { const int i = blockIdx.x * 512 + F.tid; if (i < 1024) { const int g = i >> 6; float* disc = (float*)(ws + WS_DISC);
        const float dt = expf(inp(a, 21)[l * 16 + g]), ar = inp(a, 19)[l * 1024 + i], ai = inp(a, 20)[l * 1024 + i]; const float mag = expf(ar * dt); float sn, cs; sincosf(ai * dt, &sn, &cs);
        const float lr = mag * cs, li = mag * sn, inv = 1.f / (ar * ar + ai * ai); const float zr = ((lr - 1.f) * ar + li * ai) * inv, zi = (li * ar - (lr - 1.f) * ai) * inv;
        disc[i] = lr; disc[1024 + i] = li; const float* bre = inp(a, 22) + (size_t)l * 16384 + i * 16; const float* bim = inp(a, 23) + (size_t)l * 16384 + i * 16;
        for (int hh = 0; hh < 16; ++hh) { disc[2048 + i * 16 + hh] = zr * bre[hh] - zi * bim[hh]; disc[2048 + 16384 + i * 16 + hh] = zr * bim[hh] + zi * bre[hh]; } } }
    { bf16* cc = (bf16*)(ws + WS_CC); const float* cre = inp(a, 24) + (size_t)l * 16384; const float* cim = inp(a, 25) + (size_t)l * 16384;
      for (int i = blockIdx.x * 512 + F.tid; i < 32768; i += F.G * 512) { const int gh = i >> 7, k = i & 127; cc[i] = (bf16)f2bf(k < 64 ? cre[gh * 64 + k] : -cim[gh * 64 + (k - 64)]); } }
    if (l == 0) {
        for (int m = F.gw; m < M; m += F.NGW) rms_row_to_bf16(inp(a, 0) + (size_t)m * D, inp(a, 3), (bf16*)(ws + WS_XN) + (size_t)m * D, a.out + (size_t)m * D, F.lane);
        if (blockIdx.x == 2 && F.tid < 256) { const int c = F.tid; float v[DEPTH], mx = -1e30f; for (int q = 0; q < DEPTH; ++q) { v[q] = inp(a, 10)[q * 256 + c]; mx = fmaxf(mx, v[q]); }
            float s = 0.f; for (int q = 0; q < DEPTH; ++q) { v[q] = expf(v[q] - mx); s += v[q]; } float cum = 0.f; float* lb = (float*)(ws + WS_LB);
            for (int q = 0; q < DEPTH; ++q) { cum += v[q] / s; lb[q * 256 + c] = cum - v[0] / s; } }
    }
}
__device__ __forceinline__ void phase_resid(const Frame& F_, const Args& a, const float* g1, const float* g2) {
    Frame F = F_; asm volatile("" : "+v"(F.lane)); unsigned char* ws = wsp(a);
    for (int m = F.gw; m < M; m += F.NGW) resid_norm_row(a.out + (size_t)m * D, (const float*)(ws + WS_Y) + (size_t)m * D, g1, g2, (bf16*)(ws + WS_XN) + (size_t)m * D, F.lane);
}
#define MFMA16(a, b, c) __builtin_amdgcn_mfma_f32_16x16x32_bf16((a), (b), (c), 0, 0, 0)
typedef float f32x2_t __attribute__((ext_vector_type(2))); typedef __bf16 bf16x2_t __attribute__((ext_vector_type(2)));
__device__ __forceinline__ unsigned cvtpk(float lo, float hi) { const f32x2_t v = {lo, hi}; const bf16x2_t b = __builtin_convertvector(v, bf16x2_t); return __builtin_bit_cast(unsigned, b); }
__device__ __forceinline__ bf16x8 ldsA(const LAS unsigned char* base, int row, int pitchB, int kelem) { return *(const LAS bf16x8*)(base + row * pitchB + kelem * 2); }
__device__ __forceinline__ bf16x8 gldB(const bf16* base, int row, int pitchE, int kelem) { return *(const bf16x8*)(base + (size_t)row * pitchE + kelem); }
typedef unsigned long long u64;
__device__ __forceinline__ bf16x8 mk8(u64 lo, u64 hi) { typedef u64 u64x2 __attribute__((ext_vector_type(2))); u64x2 v; v.x = lo; v.y = hi; return __builtin_bit_cast(bf16x8, v); }
__device__ __forceinline__ void wg_barrier() { asm volatile("s_waitcnt vmcnt(0) lgkmcnt(0)" ::: "memory"); __builtin_amdgcn_s_barrier(); asm volatile("" ::: "memory"); }
__device__ __forceinline__ void lds_barrier() { asm volatile("s_waitcnt lgkmcnt(0)" ::: "memory"); __builtin_amdgcn_s_barrier(); asm volatile("" ::: "memory"); }
__device__ __forceinline__ void mla_proj_chunk(LAS unsigned char* lds, unsigned char* ws, const float* __restrict__ qn, const float* __restrict__ kvn, const int* __restrict__ pos, int chunk, int tid) {
    const bf16* P = (const bf16*)(ws + WS_P); bf16* QMb = (bf16*)(ws + WS_QMB); bf16* KMb = (bf16*)(ws + WS_KMB); bf16* VT = (bf16*)(ws + WS_VT);
    const bf16* WUQ = (const bf16*)(ws + WS_WT_UQ); const bf16* WUKV = (const bf16*)(ws + WS_WT_UKV);
    const int lane = tid & 63, w = __builtin_amdgcn_readfirstlane(tid >> 6), fr = lane & 15, fq = lane >> 4; const int tok0 = chunk * 64;
    LAS unsigned char* AQ = lds; LAS unsigned char* AKV = lds + 33792; LAS unsigned char* VS = lds + 51200;
    {
        const int r = tid >> 3, sub = tid & 7; const bf16* prow = P + (size_t)(tok0 + r) * NP;
        float v[32]; float ss = 0.f;
#pragma unroll
        for (int j = 0; j < 4; ++j) { const v4u q = *(const v4u*)(prow + PQ + sub * 32 + 8 * j);
#pragma unroll
            for (int e = 0; e < 4; ++e) { const unsigned u = q[e]; v[j * 8 + 2 * e] = __uint_as_float(u << 16); v[j * 8 + 2 * e + 1] = __uint_as_float(u & 0xffff0000u); } }
#pragma unroll
        for (int j = 0; j < 32; ++j) ss += v[j] * v[j];
        ss += __shfl_xor(ss, 1); ss += __shfl_xor(ss, 2); ss += __shfl_xor(ss, 4);
        const float rq = rsqrtf(ss * (1.f / 256) + EPS);
#pragma unroll
        for (int j = 0; j < 4; ++j) { const f32x4 g0 = *(const f32x4*)(qn + sub * 32 + 8 * j), g1 = *(const f32x4*)(qn + sub * 32 + 8 * j + 4); v4u o;
            o.x = cvtpk(v[j * 8 + 0] * rq * g0[0], v[j * 8 + 1] * rq * g0[1]); o.y = cvtpk(v[j * 8 + 2] * rq * g0[2], v[j * 8 + 3] * rq * g0[3]);
            o.z = cvtpk(v[j * 8 + 4] * rq * g1[0], v[j * 8 + 5] * rq * g1[1]); o.w = cvtpk(v[j * 8 + 6] * rq * g1[2], v[j * 8 + 7] * rq * g1[3]);
            *(LAS v4u*)(AQ + r * 528 + (sub * 32 + 8 * j) * 2) = o; }
        float k[16]; float s2 = 0.f;
#pragma unroll
        for (int j = 0; j < 2; ++j) { const v4u q = *(const v4u*)(prow + PKV + sub * 16 + 8 * j);
#pragma unroll
            for (int e = 0; e < 4; ++e) { const unsigned u = q[e]; k[j * 8 + 2 * e] = __uint_as_float(u << 16); k[j * 8 + 2 * e + 1] = __uint_as_float(u & 0xffff0000u); } }
#pragma unroll
        for (int j = 0; j < 16; ++j) s2 += k[j] * k[j];
        s2 += __shfl_xor(s2, 1); s2 += __shfl_xor(s2, 2); s2 += __shfl_xor(s2, 4);
        const float rk = rsqrtf(s2 * (1.f / 128) + EPS);
#pragma unroll
        for (int j = 0; j < 2; ++j) { const f32x4 g0 = *(const f32x4*)(kvn + sub * 16 + 8 * j), g1 = *(const f32x4*)(kvn + sub * 16 + 8 * j + 4); v4u o;
            o.x = cvtpk(k[j * 8 + 0] * rk * g0[0], k[j * 8 + 1] * rk * g0[1]); o.y = cvtpk(k[j * 8 + 2] * rk * g0[2], k[j * 8 + 3] * rk * g0[3]);
            o.z = cvtpk(k[j * 8 + 4] * rk * g1[0], k[j * 8 + 5] * rk * g1[1]); o.w = cvtpk(k[j * 8 + 6] * rk * g1[2], k[j * 8 + 7] * rk * g1[3]);
            *(LAS v4u*)(AKV + r * 272 + (sub * 16 + 8 * j) * 2) = o; }
    }
    lds_barrier();
    const float scale = 0.10206207261596577f;
    {
        f32x4 acc[4][3];
#pragma unroll
        for (int mt = 0; mt < 4; ++mt)
#pragma unroll
            for (int nt = 0; nt < 3; ++nt) acc[mt][nt] = (f32x4){0.f, 0.f, 0.f, 0.f};
#pragma unroll 2
        for (int k0 = 0; k0 < 256; k0 += 32) { bf16x8 a[4], b[3];
#pragma unroll
            for (int mt = 0; mt < 4; ++mt) a[mt] = ldsA(AQ, 16 * mt + fr, 528, k0 + 8 * fq);
#pragma unroll
            for (int nt = 0; nt < 3; ++nt) b[nt] = gldB(WUQ, 48 * w + 16 * nt + fr, 256, k0 + 8 * fq);
#pragma unroll
            for (int mt = 0; mt < 4; ++mt)
#pragma unroll
                for (int nt = 0; nt < 3; ++nt) acc[mt][nt] = MFMA16(b[nt], a[mt], acc[mt][nt]); }
        const int h = w >> 1; const bool odd = (w & 1) != 0;
#pragma unroll
        for (int mt = 0; mt < 4; ++mt) { const int tok = tok0 + 16 * mt + fr;
            if (odd) { const float ps = (float)pos[tok];
#pragma unroll
                for (int i = 0; i < 4; ++i) { const int jj = 4 * fq + i; const float ang = ps * exp2f(-(float)jj * 0.8304820237218407f); float sn, cs; sincosf(ang, &sn, &cs);
                    const float x1 = acc[mt][1][i], x2 = acc[mt][2][i]; acc[mt][1][i] = x1 * cs - x2 * sn; acc[mt][2][i] = x2 * cs + x1 * sn; } }
#pragma unroll
            for (int nt = 0; nt < 3; ++nt) { const int c = h * 96 + 48 * (w & 1) + 16 * nt + 4 * fq; const f32x4 o = acc[mt][nt] * scale;
                v2u pk; pk.x = cvtpk(o[0], o[1]); pk.y = cvtpk(o[2], o[3]); *(v2u*)(QMb + (size_t)tok * 384 + c) = pk; } }
    }
    {
        f32x4 acc[4][4];
#pragma unroll
        for (int mt = 0; mt < 4; ++mt)
#pragma unroll
            for (int nt = 0; nt < 4; ++nt) acc[mt][nt] = (f32x4){0.f, 0.f, 0.f, 0.f};
#pragma unroll 2
        for (int k0 = 0; k0 < 128; k0 += 32) { bf16x8 a[4], b[4];
#pragma unroll
            for (int mt = 0; mt < 4; ++mt) a[mt] = ldsA(AKV, 16 * mt + fr, 272, k0 + 8 * fq);
#pragma unroll
            for (int nt = 0; nt < 4; ++nt) b[nt] = gldB(WUKV, 64 * w + 16 * nt + fr, 128, k0 + 8 * fq);
#pragma unroll
            for (int mt = 0; mt < 4; ++mt)
#pragma unroll
                for (int nt = 0; nt < 4; ++nt) acc[mt][nt] = MFMA16(b[nt], a[mt], acc[mt][nt]); }
        const int h = w >> 1;
#pragma unroll
        for (int mt = 0; mt < 4; ++mt) { const int row = 16 * mt + fr;
#pragma unroll
            for (int nt = 0; nt < 4; ++nt) { const f32x4 o = acc[mt][nt]; v2u pk; pk.x = cvtpk(o[0], o[1]); pk.y = cvtpk(o[2], o[3]);
                if ((w & 1) == 0) *(v2u*)(KMb + (size_t)(tok0 + row) * 384 + h * 96 + 16 * nt + 4 * fq) = pk;
                else *(LAS v2u*)(VS + row * 528 + (h * 64 + 16 * nt + 4 * fq) * 2) = pk; } }
    }
    for (int it = tid; it < 1024; it += 512) { const int row = it >> 4, jj = it & 15; const int tok = tok0 + row; const bf16* prow = P + (size_t)tok * NP + PKR;
        const float ang = (float)pos[tok] * exp2f(-(float)jj * 0.8304820237218407f); float sn, cs; sincosf(ang, &sn, &cs);
        const float x1 = bf2f(prow[jj]), x2 = bf2f(prow[16 + jj]); const bf16 o1 = (bf16)f2bf(x1 * cs - x2 * sn), o2 = (bf16)f2bf(x2 * cs + x1 * sn);
#pragma unroll
        for (int h = 0; h < 4; ++h) { KMb[(size_t)tok * 384 + h * 96 + 64 + jj] = o1; KMb[(size_t)tok * 384 + h * 96 + 80 + jj] = o2; } }
    lds_barrier();
    {
        const int he = tid >> 1, half = tid & 1; const int b = tok0 / T, t0 = tok0 % T + 32 * half; unsigned pk[16];
#pragma unroll
        for (int j = 0; j < 16; ++j) { const unsigned lo = *(const LAS unsigned short*)(VS + (32 * half + 2 * j) * 528 + he * 2), hi = *(const LAS unsigned short*)(VS + (32 * half + 2 * j + 1) * 528 + he * 2); pk[j] = lo | (hi << 16); }
        v4u* dst = (v4u*)(VT + ((size_t)(b * 256 + he)) * T + t0);
#pragma unroll
        for (int j = 0; j < 4; ++j) { v4u o; o.x = pk[4 * j]; o.y = pk[4 * j + 1]; o.z = pk[4 * j + 2]; o.w = pk[4 * j + 3]; dst[j] = o; }
    }
    lds_barrier();
}
__device__ __forceinline__ void mla_attn_unit(LAS unsigned char* lds, unsigned char* ws, int unit, int tid) {
    const bf16* QMb = (const bf16*)(ws + WS_QMB); const bf16* KMb = (const bf16*)(ws + WS_KMB); const bf16* VT = (const bf16*)(ws + WS_VT); bf16* BR = (bf16*)(ws + WS_BR);
    const int lane = tid & 63, w = __builtin_amdgcn_readfirstlane(tid >> 6), fr = lane & 15, fq = lane >> 4;
    const int qi = unit & 7, bh = unit >> 3, b = bh >> 2, h = bh & 3;
    LAS unsigned char* KS = lds; LAS unsigned char* VTS = lds + 13312;
    const bf16* Kbase = KMb + (size_t)b * T * 384 + h * 96; const bf16* Vbase = VT + (size_t)bh * 64 * T;
    const int kr0 = tid / 12, kc0 = tid % 12, kr1 = (tid + 512) / 12, kc1 = (tid + 512) % 12; const bool has1 = tid < 256; const int vr = tid >> 3, vc = tid & 7;
#pragma unroll 1
    for (int half = 0; half < 2; ++half) {
        const int qb = half ? 15 - qi : qi; const int q0 = qb * 128 + 16 * w; const int ntile = 2 * qb + 2;
        bf16x8 qf[3];
#pragma unroll
        for (int ks = 0; ks < 3; ++ks) qf[ks] = *(const bf16x8*)(QMb + ((size_t)b * T + q0 + fr) * 384 + h * 96 + 32 * ks + 8 * fq);
        f32x4 o[4]; float m = -1e30f, l = 0.f;
#pragma unroll
        for (int nt = 0; nt < 4; ++nt) o[nt] = (f32x4){0.f, 0.f, 0.f, 0.f};
        v4u k0r, k1r = (v4u){0u, 0u, 0u, 0u}, vr_;
        k0r = *(const v4u*)(Kbase + (size_t)kr0 * 384 + kc0 * 8); if (has1) k1r = *(const v4u*)(Kbase + (size_t)kr1 * 384 + kc1 * 8); vr_ = *(const v4u*)(Vbase + (size_t)vr * T + vc * 8);
#pragma unroll 1
        for (int kt = 0; kt < ntile; ++kt) {
            lds_barrier();
            *(LAS v4u*)(KS + kr0 * 208 + kc0 * 16) = k0r; if (has1) *(LAS v4u*)(KS + kr1 * 208 + kc1 * 16) = k1r; *(LAS v4u*)(VTS + vr * 144 + vc * 16) = vr_;
            lds_barrier();
            if (kt + 1 < ntile) { const int kn = (kt + 1) * 64;
                k0r = *(const v4u*)(Kbase + (size_t)(kn + kr0) * 384 + kc0 * 8); if (has1) k1r = *(const v4u*)(Kbase + (size_t)(kn + kr1) * 384 + kc1 * 8); vr_ = *(const v4u*)(Vbase + (size_t)vr * T + kn + vc * 8); }
            f32x4 s[4];
#pragma unroll
            for (int nt = 0; nt < 4; ++nt) { s[nt] = (f32x4){0.f, 0.f, 0.f, 0.f};
#pragma unroll
                for (int ks = 0; ks < 3; ++ks) s[nt] = MFMA16(ldsA(KS, 16 * nt + fr, 208, 32 * ks + 8 * fq), qf[ks], s[nt]); }
            if (kt >= ntile - 2) { const int row = q0 + fr;
#pragma unroll
                for (int nt = 0; nt < 4; ++nt)
#pragma unroll
                    for (int i = 0; i < 4; ++i) { const int key = kt * 64 + 16 * nt + 4 * fq + i; if (key > row) s[nt][i] = -1e30f; } }
            float mx = -1e30f;
#pragma unroll
            for (int nt = 0; nt < 4; ++nt)
#pragma unroll
                for (int i = 0; i < 4; ++i) mx = fmaxf(mx, s[nt][i]);
            mx = fmaxf(mx, __shfl_xor(mx, 16)); mx = fmaxf(mx, __shfl_xor(mx, 32));
            const float mn = fmaxf(m, mx), alpha = __expf(m - mn); float rs = 0.f;
#pragma unroll
            for (int nt = 0; nt < 4; ++nt)
#pragma unroll
                for (int i = 0; i < 4; ++i) { const float p = __expf(s[nt][i] - mn); s[nt][i] = p; rs += p; }
            rs += __shfl_xor(rs, 16); rs += __shfl_xor(rs, 32);
            l = l * alpha + rs; m = mn;
#pragma unroll
            for (int nt = 0; nt < 4; ++nt) o[nt] = o[nt] * alpha;
#pragma unroll
            for (int k2 = 0; k2 < 2; ++k2) { v4u pw; pw.x = cvtpk(s[2 * k2][0], s[2 * k2][1]); pw.y = cvtpk(s[2 * k2][2], s[2 * k2][3]); pw.z = cvtpk(s[2 * k2 + 1][0], s[2 * k2 + 1][1]); pw.w = cvtpk(s[2 * k2 + 1][2], s[2 * k2 + 1][3]);
                const bf16x8 pf = __builtin_bit_cast(bf16x8, pw);
#pragma unroll
                for (int nt = 0; nt < 4; ++nt) { const LAS unsigned char* vp = VTS + (16 * nt + fr) * 144 + (32 * k2 + 4 * fq) * 2;
                    const bf16x8 vf = mk8(*(const LAS u64*)vp, *(const LAS u64*)(vp + 32)); o[nt] = MFMA16(vf, pf, o[nt]); } }
        }
        const float il = 1.f / l;
#pragma unroll
        for (int nt = 0; nt < 4; ++nt) { const f32x4 ov = o[nt] * il; v2u pk; pk.x = cvtpk(ov[0], ov[1]); pk.y = cvtpk(ov[2], ov[3]);
            *(v2u*)(BR + ((size_t)b * T + q0 + fr) * 1024 + h * 64 + 16 * nt + 4 * fq) = pk; }
    }
    lds_barrier();
}
__device__ __forceinline__ void s5_load_u(LAS unsigned char* US, const bf16* P, int tok0, int tid) {
    const int r = tid >> 3, sub = tid & 7; const bf16* prow = P + (size_t)(tok0 + r) * NP + PDU + sub * 32;
#pragma unroll
    for (int j = 0; j < 4; ++j) *(LAS v4u*)(US + r * 528 + (sub * 32 + 8 * j) * 2) = *(const v4u*)(prow + 8 * j);
}
__device__ __forceinline__ void s5_x(const LAS unsigned char* up, const float (&br)[16], const float (&bi)[16], float& xr, float& xi) {
    const v4u u0 = *(const LAS v4u*)up, u1 = *(const LAS v4u*)(up + 16); xr = 0.f; xi = 0.f;
#pragma unroll
    for (int e = 0; e < 4; ++e) { const float a = __uint_as_float(u0[e] << 16), b = __uint_as_float(u0[e] & 0xffff0000u); xr += br[2 * e] * a + br[2 * e + 1] * b; xi += bi[2 * e] * a + bi[2 * e + 1] * b; }
#pragma unroll
    for (int e = 0; e < 4; ++e) { const float a = __uint_as_float(u1[e] << 16), b = __uint_as_float(u1[e] & 0xffff0000u); xr += br[8 + 2 * e] * a + br[8 + 2 * e + 1] * b; xi += bi[8 + 2 * e] * a + bi[8 + 2 * e + 1] * b; }
}
__device__ __forceinline__ void s5_local_chunk(LAS unsigned char* lds, unsigned char* ws, int chunk, int tid) {
    const bf16* P = (const bf16*)(ws + WS_P); const float* DISC = (const float*)(ws + WS_DISC); float* S5E = (float*)(ws + WS_S5E);
    const int lane = tid & 63, w = __builtin_amdgcn_readfirstlane(tid >> 6); LAS unsigned char* US = lds;
    s5_load_u(US, P, chunk * 64, tid); wg_barrier();
#pragma unroll 1
    for (int gi = 0; gi < 2; ++gi) { const int g = 2 * w + gi, gp = g * 64 + lane; const float lr = DISC[gp], li = DISC[1024 + gp]; float br[16], bi[16];
#pragma unroll
        for (int q = 0; q < 4; ++q) { const f32x4 a = *(const f32x4*)(DISC + 2048 + gp * 16 + 4 * q), b = *(const f32x4*)(DISC + 2048 + 16384 + gp * 16 + 4 * q);
#pragma unroll
            for (int e = 0; e < 4; ++e) { br[4 * q + e] = a[e]; bi[4 * q + e] = b[e]; } }
        float sr = 0.f, si = 0.f;
#pragma unroll 4
        for (int t = 0; t < 64; ++t) { float xr, xi; s5_x(US + t * 528 + g * 32, br, bi, xr, xi); const float nr = lr * sr - li * si + xr, ni = lr * si + li * sr + xi; sr = nr; si = ni; }
        *(float2*)(S5E + ((size_t)chunk * 1024 + gp) * 2) = make_float2(sr, si); }
    lds_barrier();
}
__device__ __forceinline__ void s5_prefix(unsigned char* ws, int idx) {
    const float* DISC = (const float*)(ws + WS_DISC); float* S5E = (float*)(ws + WS_S5E);
    const int b = idx >> 10, gp = idx & 1023; float lr = DISC[gp], li = DISC[1024 + gp];
#pragma unroll
    for (int q = 0; q < 6; ++q) { const float nr = lr * lr - li * li, ni = 2.f * lr * li; lr = nr; li = ni; }
    float sr = 0.f, si = 0.f;
#pragma unroll 4
    for (int ci = 0; ci < 32; ++ci) { float2* p = (float2*)(S5E + ((size_t)(b * 32 + ci) * 1024 + gp) * 2); const float2 e = *p; *p = make_float2(sr, si);
        const float nr = lr * sr - li * si + e.x, ni = lr * si + li * sr + e.y; sr = nr; si = ni; }
}
__device__ __forceinline__ void s5_out_chunk(LAS unsigned char* lds, unsigned char* ws, const float* __restrict__ dvec, const float* __restrict__ bglu, int chunk, int tid) {
    const bf16* P = (const bf16*)(ws + WS_P); const float* DISC = (const float*)(ws + WS_DISC); const float* S5E = (const float*)(ws + WS_S5E); const bf16* CC = (const bf16*)(ws + WS_CC);
    const bf16* WGLU = (const bf16*)(ws + WS_WT_GLU); bf16* BR = (bf16*)(ws + WS_BR);
    const int lane = tid & 63, w = __builtin_amdgcn_readfirstlane(tid >> 6), fr = lane & 15, fq = lane >> 4; const int tok0 = chunk * 64;
    LAS unsigned char* US = lds; LAS unsigned char* YG = lds + 33792; LAS unsigned char* ST = lds + 67584 + w * 4352;
    s5_load_u(US, P, tok0, tid); wg_barrier();
#pragma unroll 1
    for (int gi = 0; gi < 2; ++gi) { const int g = 2 * w + gi, gp = g * 64 + lane; const float lr = DISC[gp], li = DISC[1024 + gp]; float br[16], bi[16];
#pragma unroll
        for (int q = 0; q < 4; ++q) { const f32x4 a = *(const f32x4*)(DISC + 2048 + gp * 16 + 4 * q), b = *(const f32x4*)(DISC + 2048 + 16384 + gp * 16 + 4 * q);
#pragma unroll
            for (int e = 0; e < 4; ++e) { br[4 * q + e] = a[e]; bi[4 * q + e] = b[e]; } }
        const float2 s0 = *(const float2*)(S5E + ((size_t)chunk * 1024 + gp) * 2); float sr = s0.x, si = s0.y;
        bf16x8 cb[4];
#pragma unroll
        for (int ks = 0; ks < 4; ++ks) cb[ks] = gldB(CC, g * 16 + fr, 128, 32 * ks + 8 * fq);
        const f32x4 dv = *(const f32x4*)(dvec + g * 16 + 4 * fq);
#pragma unroll 1
        for (int sub = 0; sub < 4; ++sub) {
#pragma unroll 4
            for (int tt = 0; tt < 16; ++tt) { float xr, xi; s5_x(US + (16 * sub + tt) * 528 + g * 32, br, bi, xr, xi); const float nr = lr * sr - li * si + xr, ni = lr * si + li * sr + xi; sr = nr; si = ni;
                *(LAS unsigned short*)(ST + tt * 272 + lane * 2) = (unsigned short)f2bf(sr); *(LAS unsigned short*)(ST + tt * 272 + (64 + lane) * 2) = (unsigned short)f2bf(si); }
            asm volatile("s_waitcnt lgkmcnt(0)" ::: "memory");
            f32x4 y = (f32x4){0.f, 0.f, 0.f, 0.f};
#pragma unroll
            for (int ks = 0; ks < 4; ++ks) y = MFMA16(cb[ks], ldsA(ST, fr, 272, 32 * ks + 8 * fq), y);
            const int trow = 16 * sub + fr; const v2u uu = *(const LAS v2u*)(US + trow * 528 + (g * 16 + 4 * fq) * 2);
            float uv[4] = {__uint_as_float(uu.x << 16), __uint_as_float(uu.x & 0xffff0000u), __uint_as_float(uu.y << 16), __uint_as_float(uu.y & 0xffff0000u)}; float o[4];
#pragma unroll
            for (int i = 0; i < 4; ++i) { const float x = y[i] + dv[i] * uv[i]; o[i] = x / (1.f + __expf(-1.5957691216057308f * (x + 0.044715f * x * x * x))); }
            v2u pk; pk.x = cvtpk(o[0], o[1]); pk.y = cvtpk(o[2], o[3]); *(LAS v2u*)(YG + trow * 528 + (g * 16 + 4 * fq) * 2) = pk;
            asm volatile("s_waitcnt lgkmcnt(0)" ::: "memory");
        }
    }
    lds_barrier();
    {
        f32x4 acc[4][2];
#pragma unroll
        for (int mt = 0; mt < 4; ++mt)
#pragma unroll
            for (int nt = 0; nt < 2; ++nt) acc[mt][nt] = (f32x4){0.f, 0.f, 0.f, 0.f};
#pragma unroll 2
        for (int k0 = 0; k0 < 256; k0 += 32) { bf16x8 a[4], b[2];
#pragma unroll
            for (int mt = 0; mt < 4; ++mt) a[mt] = ldsA(YG, 16 * mt + fr, 528, k0 + 8 * fq);
#pragma unroll
            for (int nt = 0; nt < 2; ++nt) b[nt] = gldB(WGLU, 32 * w + 16 * nt + fr, 256, k0 + 8 * fq);
#pragma unroll
            for (int mt = 0; mt < 4; ++mt)
#pragma unroll
                for (int nt = 0; nt < 2; ++nt) acc[mt][nt] = MFMA16(b[nt], a[mt], acc[mt][nt]); }
#pragma unroll
        for (int mt = 0; mt < 4; ++mt)
#pragma unroll
            for (int nt = 0; nt < 2; ++nt) { const int row = 16 * mt + fr, col = 32 * w + 16 * nt + 4 * fq; const f32x4 bg = *(const f32x4*)(bglu + col);
                const v2u yy = *(const LAS v2u*)(YG + row * 528 + col * 2); const float yv[4] = {__uint_as_float(yy.x << 16), __uint_as_float(yy.x & 0xffff0000u), __uint_as_float(yy.y << 16), __uint_as_float(yy.y & 0xffff0000u)}; float o[4];
#pragma unroll
                for (int i = 0; i < 4; ++i) o[i] = yv[i] / (1.f + __expf(-(acc[mt][nt][i] + bg[i])));
                v2u pk; pk.x = cvtpk(o[0], o[1]); pk.y = cvtpk(o[2], o[3]); *(v2u*)(BR + (size_t)(tok0 + row) * 1024 + 768 + col) = pk; }
    }
    lds_barrier();
}
__device__ __forceinline__ void stage_vt(LAS unsigned char* VT, const bf16* Pcol, int c) {
#pragma unroll 2
    for (int j = 0; j < 8; ++j) { unsigned pk[4];
#pragma unroll
        for (int e = 0; e < 4; ++e) { const unsigned lo = Pcol[(size_t)(8 * j + 2 * e) * NP + c], hi = Pcol[(size_t)(8 * j + 2 * e + 1) * NP + c]; pk[e] = lo | (hi << 16); }
        *(LAS v4u*)(VT + c * 144 + 16 * j) = (v4u){pk[0], pk[1], pk[2], pk[3]}; }
}
__device__ __forceinline__ void kv_end_mfma(const LAS unsigned char* VT, const LAS unsigned char* KT, bf16* dst, int w, int fr, int fq) {
    const int h = w >> 1, e0 = 32 * (w & 1); f32x4 acc[2][4];
#pragma unroll
    for (int mt = 0; mt < 2; ++mt)
#pragma unroll
        for (int nt = 0; nt < 4; ++nt) acc[mt][nt] = (f32x4){0.f, 0.f, 0.f, 0.f};
#pragma unroll
    for (int ks = 0; ks < 2; ++ks) { bf16x8 a[2], b[4];
#pragma unroll
        for (int mt = 0; mt < 2; ++mt) a[mt] = ldsA(VT, h * 64 + e0 + 16 * mt + fr, 144, 32 * ks + 8 * fq);
#pragma unroll
        for (int nt = 0; nt < 4; ++nt) b[nt] = ldsA(KT, h * 64 + 16 * nt + fr, 144, 32 * ks + 8 * fq);
#pragma unroll
        for (int mt = 0; mt < 2; ++mt)
#pragma unroll
            for (int nt = 0; nt < 4; ++nt) acc[mt][nt] = MFMA16(b[nt], a[mt], acc[mt][nt]); }
#pragma unroll
    for (int mt = 0; mt < 2; ++mt)
#pragma unroll
        for (int nt = 0; nt < 4; ++nt) { v2u pk; pk.x = cvtpk(acc[mt][nt][0], acc[mt][nt][1]); pk.y = cvtpk(acc[mt][nt][2], acc[mt][nt][3]);
            *(v2u*)(dst + (size_t)(h * 64 + e0 + 16 * mt + fr) * 64 + 16 * nt + 4 * fq) = pk; }
}
__device__ __forceinline__ void hg_local_chunk(LAS unsigned char* lds, unsigned char* ws, const float* __restrict__ lbv, int chunk, int tid) {
    const bf16* P = (const bf16*)(ws + WS_P); bf16* KVH = (bf16*)(ws + WS_KVH); float* DEC = (float*)(ws + WS_DEC); float* BREF = (float*)(ws + WS_BREF);
    const int lane = tid & 63, w = __builtin_amdgcn_readfirstlane(tid >> 6), fr = lane & 15, fq = lane >> 4; const int tok0 = chunk * 64;
    LAS unsigned char* KT = lds; LAS unsigned char* VT = lds + 36864;
    if (tid < 256) { const int c = tid; const float lb = lbv[c]; const bf16* pf = P + (size_t)tok0 * NP + PBF + c; float suffix = 0.f, suf32 = 0.f;
#pragma unroll 1
        for (int j = 7; j >= 0; --j) { float kv[8];
#pragma unroll
            for (int e = 7; e >= 0; --e) { const int s = 8 * j + e; const float x = bf2f(pf[(size_t)s * NP]); const float sg = 1.f / (1.f + __expf(-x));
                const float f = fmaxf(lb + (1.f - lb) * sg, 1e-30f); kv[e] = (1.f - lb) * (1.f - sg) * __expf(suffix); suffix += __logf(f); }
            if (j == 4) suf32 = suffix;
            *(LAS v4u*)(KT + c * 144 + 16 * j) = (v4u){cvtpk(kv[0], kv[1]), cvtpk(kv[2], kv[3]), cvtpk(kv[4], kv[5]), cvtpk(kv[6], kv[7])}; }
        DEC[chunk * 256 + c] = __expf(suffix); BREF[chunk * 256 + c] = suffix - suf32;
    } else stage_vt(VT, P + (size_t)tok0 * NP + PBI, tid - 256);
    wg_barrier();
    kv_end_mfma(VT, KT, KVH + (size_t)chunk * 16384, w, fr, fq);
    lds_barrier();
}
__device__ __forceinline__ void hg_scan(unsigned char* ws, int idx) {
    bf16* KVH = (bf16*)(ws + WS_KVH); const float* DEC = (const float*)(ws + WS_DEC); const float* BREF = (const float*)(ws + WS_BREF);
    const int b = idx >> 14, r = idx & 16383, h = r >> 12, d = r & 63; float S = 0.f;
#pragma unroll 4
    for (int ci = 0; ci < 32; ++ci) { const int chunk = b * 32 + ci; bf16* p = KVH + (size_t)chunk * 16384 + r; const float kv = bf2f(*p); const float dec = DEC[chunk * 256 + h * 64 + d], br = BREF[chunk * 256 + h * 64 + d];
        *p = (bf16)f2bf(S * __expf(br)); S = dec * S + kv; }
}
__device__ __forceinline__ void hg_out_chunk(LAS unsigned char* lds, unsigned char* ws, const float* __restrict__ lbv, const float* __restrict__ onorm, int chunk, int tid) {
    const bf16* P = (const bf16*)(ws + WS_P); const bf16* S0H = (const bf16*)(ws + WS_KVH); const float* BREF = (const float*)(ws + WS_BREF); bf16* BR = (bf16*)(ws + WS_BR);
    const int lane = tid & 63, w = __builtin_amdgcn_readfirstlane(tid >> 6), fr = lane & 15, fq = lane >> 4; const int tok0 = chunk * 64;
    LAS unsigned char* QT = lds; LAS unsigned char* KT2 = lds + 33792; LAS unsigned char* VT = lds + 67584;
    if (tid < 256) { const int c = tid; const float lb = lbv[c], bref = BREF[chunk * 256 + c]; const bf16* pf = P + (size_t)tok0 * NP + PBF + c; const bf16* pq = P + (size_t)tok0 * NP + PBQ + c; float bsum = 0.f;
#pragma unroll 4
        for (int s = 0; s < 64; ++s) { const float x = bf2f(pf[(size_t)s * NP]), qx = bf2f(pq[(size_t)s * NP]); const float sg = 1.f / (1.f + __expf(-x));
            const float f = fmaxf(lb + (1.f - lb) * sg, 1e-30f); bsum += __logf(f); const float e1 = bsum - bref;
            const float qv = qx / (1.f + __expf(-qx)) * __expf(fminf(e1, 80.f)), kv = (1.f - lb) * (1.f - sg) * __expf(fminf(-e1, 80.f));
            *(LAS unsigned short*)(QT + s * 528 + c * 2) = (unsigned short)f2bf(qv); *(LAS unsigned short*)(KT2 + s * 528 + c * 2) = (unsigned short)f2bf(kv); }
    } else stage_vt(VT, P + (size_t)tok0 * NP + PBI, tid - 256);
    wg_barrier();
    const int h = w >> 1, t0 = 32 * (w & 1); const bf16* S0 = S0H + (size_t)chunk * 16384 + h * 4096;
    bf16x8 a[2][2];
#pragma unroll
    for (int mt = 0; mt < 2; ++mt)
#pragma unroll
        for (int ks = 0; ks < 2; ++ks) a[mt][ks] = ldsA(QT, t0 + 16 * mt + fr, 528, h * 64 + 32 * ks + 8 * fq);
    f32x4 sc[2][4], o[2][4];
#pragma unroll
    for (int nt = 0; nt < 4; ++nt) { bf16x8 kb[2], sb[2];
#pragma unroll
        for (int ks = 0; ks < 2; ++ks) { kb[ks] = ldsA(KT2, 16 * nt + fr, 528, h * 64 + 32 * ks + 8 * fq); sb[ks] = gldB(S0, 16 * nt + fr, 64, 32 * ks + 8 * fq); }
#pragma unroll
        for (int mt = 0; mt < 2; ++mt) { f32x4 s = (f32x4){0.f, 0.f, 0.f, 0.f}, oo = (f32x4){0.f, 0.f, 0.f, 0.f};
#pragma unroll
            for (int ks = 0; ks < 2; ++ks) { s = MFMA16(kb[ks], a[mt][ks], s); oo = MFMA16(sb[ks], a[mt][ks], oo); }
            const int t = t0 + 16 * mt + fr;
#pragma unroll
            for (int i = 0; i < 4; ++i) if (16 * nt + 4 * fq + i > t) s[i] = 0.f;
            sc[mt][nt] = s; o[mt][nt] = oo; } }
#pragma unroll
    for (int k2 = 0; k2 < 2; ++k2) { bf16x8 pf[2];
#pragma unroll
        for (int mt = 0; mt < 2; ++mt) { v4u pw; pw.x = cvtpk(sc[mt][2 * k2][0], sc[mt][2 * k2][1]); pw.y = cvtpk(sc[mt][2 * k2][2], sc[mt][2 * k2][3]); pw.z = cvtpk(sc[mt][2 * k2 + 1][0], sc[mt][2 * k2 + 1][1]); pw.w = cvtpk(sc[mt][2 * k2 + 1][2], sc[mt][2 * k2 + 1][3]); pf[mt] = __builtin_bit_cast(bf16x8, pw); }
#pragma unroll
        for (int nt = 0; nt < 4; ++nt) { const LAS unsigned char* vp = VT + (h * 64 + 16 * nt + fr) * 144 + (32 * k2 + 4 * fq) * 2; const bf16x8 vf = mk8(*(const LAS u64*)vp, *(const LAS u64*)(vp + 32));
#pragma unroll
            for (int mt = 0; mt < 2; ++mt) o[mt][nt] = MFMA16(vf, pf[mt], o[mt][nt]); } }
#pragma unroll
    for (int mt = 0; mt < 2; ++mt) { float ss = 0.f;
#pragma unroll
        for (int nt = 0; nt < 4; ++nt)
#pragma unroll
            for (int i = 0; i < 4; ++i) ss += o[mt][nt][i] * o[mt][nt][i];
        ss += __shfl_xor(ss, 16); ss += __shfl_xor(ss, 32); const float r = rsqrtf(ss * (1.f / 64) + EPS); const int tok = tok0 + t0 + 16 * mt + fr;
#pragma unroll
        for (int nt = 0; nt < 4; ++nt) { const int c = h * 64 + 16 * nt + 4 * fq; const f32x4 g = *(const f32x4*)(onorm + c); const v2u gg = *(const v2u*)(P + (size_t)tok * NP + PBG + c);
            const float gx[4] = {__uint_as_float(gg.x << 16), __uint_as_float(gg.x & 0xffff0000u), __uint_as_float(gg.y << 16), __uint_as_float(gg.y & 0xffff0000u)}; float ov[4];
#pragma unroll
            for (int i = 0; i < 4; ++i) ov[i] = o[mt][nt][i] * r * g[i] * gx[i] / (1.f + __expf(-gx[i]));
            v2u pk; pk.x = cvtpk(ov[0], ov[1]); pk.y = cvtpk(ov[2], ov[3]); *(v2u*)(BR + (size_t)tok * 1024 + 256 + c) = pk; } }
    lds_barrier();
}
__device__ __forceinline__ void ml_gates(const bf16* P, const float* ib, const float* fb, int tok0, int h, int lane, float& F, float& il) {
    const bf16* p = P + (size_t)(tok0 + lane) * NP; const float z = bf2f(p[PFG + h]) + fb[h]; il = bf2f(p[PIG + h]) + ib[h];
    F = fminf(z, 0.f) - __logf(1.f + __expf(-fabsf(z)));
#pragma unroll
    for (int off = 1; off < 64; off <<= 1) { const float v = __shfl_up(F, off); if (lane >= off) F += v; }
}
__device__ __forceinline__ void ml_local_chunk(LAS unsigned char* lds, unsigned char* ws, const float* __restrict__ cw, const float* __restrict__ cb, const float* __restrict__ ib, const float* __restrict__ fb, int chunk, int tid) {
    const bf16* P = (const bf16*)(ws + WS_P); bf16* QML = (bf16*)(ws + WS_QML); bf16* KML = (bf16*)(ws + WS_KML); bf16* CH = (bf16*)(ws + WS_CH); float* NEND = (float*)(ws + WS_NEND); float* DECM = (float*)(ws + WS_DECM);
    const bf16* WQ = (const bf16*)(ws + WS_WT_MLQ); const bf16* WK = (const bf16*)(ws + WS_WT_MLK);
    const int lane = tid & 63, w = __builtin_amdgcn_readfirstlane(tid >> 6), fr = lane & 15, fq = lane >> 4; const int tok0 = chunk * 64, t00 = tok0 % T;
    LAS unsigned char* XC = lds; LAS unsigned char* KT = lds + 33792; LAS unsigned char* VT = lds + 70656; LAS float* WV = (LAS float*)(lds + 107520);
    {
        const int r = tid >> 3, sub = tid & 7;
#pragma unroll 1
        for (int j = 0; j < 4; ++j) { const int c = sub * 32 + 8 * j; float acc[8];
#pragma unroll
            for (int e = 0; e < 2; ++e) { const f32x4 bv = *(const f32x4*)(cb + c + 4 * e); acc[4 * e] = bv[0]; acc[4 * e + 1] = bv[1]; acc[4 * e + 2] = bv[2]; acc[4 * e + 3] = bv[3]; }
#pragma unroll
            for (int tap = 0; tap < 4; ++tap) { if (t00 + r - 3 + tap >= 0) { const v4u x = *(const v4u*)(P + (size_t)(tok0 + r - 3 + tap) * NP + PCX + c); const f32x4 w0 = *(const f32x4*)(cw + tap * 256 + c), w1 = *(const f32x4*)(cw + tap * 256 + c + 4);
                acc[0] += w0[0] * __uint_as_float(x.x << 16); acc[1] += w0[1] * __uint_as_float(x.x & 0xffff0000u); acc[2] += w0[2] * __uint_as_float(x.y << 16); acc[3] += w0[3] * __uint_as_float(x.y & 0xffff0000u);
                acc[4] += w1[0] * __uint_as_float(x.z << 16); acc[5] += w1[1] * __uint_as_float(x.z & 0xffff0000u); acc[6] += w1[2] * __uint_as_float(x.w << 16); acc[7] += w1[3] * __uint_as_float(x.w & 0xffff0000u); } }
#pragma unroll
            for (int e = 0; e < 8; ++e) acc[e] = acc[e] / (1.f + __expf(-acc[e]));
            *(LAS v4u*)(XC + r * 528 + c * 2) = (v4u){cvtpk(acc[0], acc[1]), cvtpk(acc[2], acc[3]), cvtpk(acc[4], acc[5]), cvtpk(acc[6], acc[7])}; }
    }
    if (w < 4) { float F, il; ml_gates(P, ib, fb, tok0, w, lane, F, il); const float Fend = __shfl(F, 63); WV[w * 64 + lane] = __expf(Fend - F + il); if (lane == 0) DECM[chunk * 4 + w] = __expf(Fend); }
    else stage_vt(VT, P + (size_t)tok0 * NP + PCV, tid - 256);
    wg_barrier();
    {
        const int h = w >> 1, e0 = 32 * (w & 1); f32x4 aq[4][2], ak[4][2];
#pragma unroll
        for (int mt = 0; mt < 4; ++mt)
#pragma unroll
            for (int nt = 0; nt < 2; ++nt) { aq[mt][nt] = (f32x4){0.f, 0.f, 0.f, 0.f}; ak[mt][nt] = (f32x4){0.f, 0.f, 0.f, 0.f}; }
#pragma unroll
        for (int ks = 0; ks < 2; ++ks) { bf16x8 a[4], bq[2], bk[2];
#pragma unroll
            for (int mt = 0; mt < 4; ++mt) a[mt] = ldsA(XC, 16 * mt + fr, 528, h * 64 + 32 * ks + 8 * fq);
#pragma unroll
            for (int nt = 0; nt < 2; ++nt) { bq[nt] = gldB(WQ, h * 64 + e0 + 16 * nt + fr, 64, 32 * ks + 8 * fq); bk[nt] = gldB(WK, h * 64 + e0 + 16 * nt + fr, 64, 32 * ks + 8 * fq); }
#pragma unroll
            for (int mt = 0; mt < 4; ++mt)
#pragma unroll
                for (int nt = 0; nt < 2; ++nt) { aq[mt][nt] = MFMA16(bq[nt], a[mt], aq[mt][nt]); ak[mt][nt] = MFMA16(bk[nt], a[mt], ak[mt][nt]); } }
#pragma unroll
        for (int mt = 0; mt < 4; ++mt) { const int s = 16 * mt + fr; const float wv = WV[h * 64 + s];
#pragma unroll
            for (int nt = 0; nt < 2; ++nt) { const int c = h * 64 + e0 + 16 * nt + 4 * fq; const f32x4 q = aq[mt][nt], k = ak[mt][nt] * 0.125f;
                v2u pq; pq.x = cvtpk(q[0], q[1]); pq.y = cvtpk(q[2], q[3]); *(v2u*)(QML + (size_t)(tok0 + s) * 256 + c) = pq;
                v2u pk; pk.x = cvtpk(k[0], k[1]); pk.y = cvtpk(k[2], k[3]); *(v2u*)(KML + (size_t)(tok0 + s) * 256 + c) = pk;
#pragma unroll
                for (int i = 0; i < 4; ++i) *(LAS unsigned short*)(KT + (c + i) * 144 + s * 2) = (unsigned short)f2bf(k[i] * wv); } }
    }
    lds_barrier();
    if (tid < 256) { float n = 0.f;
#pragma unroll
        for (int j = 0; j < 8; ++j) { const v4u q = *(const LAS v4u*)(KT + tid * 144 + 16 * j);
#pragma unroll
            for (int e = 0; e < 4; ++e) n += __uint_as_float(q[e] << 16) + __uint_as_float(q[e] & 0xffff0000u); }
        NEND[chunk * 256 + tid] = n; }
    kv_end_mfma(VT, KT, CH + (size_t)chunk * 16384, w, fr, fq);
    lds_barrier();
}
__device__ __forceinline__ void ml_scan(unsigned char* ws, int idx) {
    bf16* CH = (bf16*)(ws + WS_CH); const float* DECM = (const float*)(ws + WS_DECM); const int b = idx >> 14, r = idx & 16383, h = r >> 12; float S = 0.f;
#pragma unroll 4
    for (int ci = 0; ci < 32; ++ci) { const int chunk = b * 32 + ci; bf16* p = CH + (size_t)chunk * 16384 + r; const float kv = bf2f(*p); const float dec = DECM[chunk * 4 + h]; *p = (bf16)f2bf(S); S = dec * S + kv; }
}
__device__ __forceinline__ void ml_scan_n(unsigned char* ws, int idx) {
    float* NEND = (float*)(ws + WS_NEND); const float* DECM = (const float*)(ws + WS_DECM); const int b = idx >> 8, c = idx & 255, h = c >> 6; float n = 0.f;
#pragma unroll 4
    for (int ci = 0; ci < 32; ++ci) { const int chunk = b * 32 + ci; float* p = NEND + chunk * 256 + c; const float e = *p; *p = n; n = DECM[chunk * 4 + h] * n + e; }
}
__device__ __forceinline__ void ml_out_chunk(LAS unsigned char* lds, unsigned char* ws, const float* __restrict__ ib, const float* __restrict__ fb, const float* __restrict__ onorm, int chunk, int tid) {
    const bf16* P = (const bf16*)(ws + WS_P); const bf16* QML = (const bf16*)(ws + WS_QML); const bf16* KML = (const bf16*)(ws + WS_KML); const bf16* C0H = (const bf16*)(ws + WS_CH); const float* N0 = (const float*)(ws + WS_NEND); bf16* BR = (bf16*)(ws + WS_BR);
    const int lane = tid & 63, w = __builtin_amdgcn_readfirstlane(tid >> 6), fr = lane & 15, fq = lane >> 4; const int tok0 = chunk * 64;
    LAS unsigned char* QT = lds; LAS unsigned char* KT2 = lds + 33792; LAS unsigned char* VT = lds + 67584; LAS float* FS = (LAS float*)(lds + 104448); LAS float* IS = (LAS float*)(lds + 105472); LAS float* N0S = (LAS float*)(lds + 106496);
    { const int r = tid >> 3, sub = tid & 7;
#pragma unroll
      for (int j = 0; j < 4; ++j) { *(LAS v4u*)(QT + r * 528 + (sub * 32 + 8 * j) * 2) = *(const v4u*)(QML + (size_t)(tok0 + r) * 256 + sub * 32 + 8 * j); *(LAS v4u*)(KT2 + r * 528 + (sub * 32 + 8 * j) * 2) = *(const v4u*)(KML + (size_t)(tok0 + r) * 256 + sub * 32 + 8 * j); } }
    if (w < 4) { float F, il; ml_gates(P, ib, fb, tok0, w, lane, F, il); FS[w * 64 + lane] = F; IS[w * 64 + lane] = il; N0S[tid] = N0[chunk * 256 + tid]; }
    else stage_vt(VT, P + (size_t)tok0 * NP + PCV, tid - 256);
    wg_barrier();
    const int h = w >> 1, t0 = 32 * (w & 1); const bf16* C0 = C0H + (size_t)chunk * 16384 + h * 4096;
    bf16x8 a[2][2];
#pragma unroll
    for (int mt = 0; mt < 2; ++mt)
#pragma unroll
        for (int ks = 0; ks < 2; ++ks) a[mt][ks] = ldsA(QT, t0 + 16 * mt + fr, 528, h * 64 + 32 * ks + 8 * fq);
    float Ft[2], ef[2], den[2];
#pragma unroll
    for (int mt = 0; mt < 2; ++mt) { const int t = t0 + 16 * mt + fr; Ft[mt] = FS[h * 64 + t]; ef[mt] = __expf(Ft[mt]);
        const v4u q0 = *(const LAS v4u*)(QT + t * 528 + (h * 64 + 16 * fq) * 2), q1 = *(const LAS v4u*)(QT + t * 528 + (h * 64 + 16 * fq + 8) * 2); float qn = 0.f;
#pragma unroll
        for (int e = 0; e < 4; ++e) { qn += __uint_as_float(q0[e] << 16) * N0S[h * 64 + 16 * fq + 2 * e] + __uint_as_float(q0[e] & 0xffff0000u) * N0S[h * 64 + 16 * fq + 2 * e + 1];
            qn += __uint_as_float(q1[e] << 16) * N0S[h * 64 + 16 * fq + 8 + 2 * e] + __uint_as_float(q1[e] & 0xffff0000u) * N0S[h * 64 + 16 * fq + 8 + 2 * e + 1]; }
        qn += __shfl_xor(qn, 16); qn += __shfl_xor(qn, 32); den[mt] = ef[mt] * qn; }
    f32x4 sc[2][4], o[2][4];
#pragma unroll
    for (int nt = 0; nt < 4; ++nt) { bf16x8 kb[2], sb[2]; f32x4 Gs;
#pragma unroll
        for (int ks = 0; ks < 2; ++ks) { kb[ks] = ldsA(KT2, 16 * nt + fr, 528, h * 64 + 32 * ks + 8 * fq); sb[ks] = gldB(C0, 16 * nt + fr, 64, 32 * ks + 8 * fq); }
#pragma unroll
        for (int i = 0; i < 4; ++i) { const int s = 16 * nt + 4 * fq + i; Gs[i] = IS[h * 64 + s] - FS[h * 64 + s]; }
#pragma unroll
        for (int mt = 0; mt < 2; ++mt) { f32x4 s = (f32x4){0.f, 0.f, 0.f, 0.f}, oo = (f32x4){0.f, 0.f, 0.f, 0.f};
#pragma unroll
            for (int ks = 0; ks < 2; ++ks) { s = MFMA16(kb[ks], a[mt][ks], s); oo = MFMA16(sb[ks], a[mt][ks], oo); }
            const int t = t0 + 16 * mt + fr;
#pragma unroll
            for (int i = 0; i < 4; ++i) { const float wgt = (16 * nt + 4 * fq + i > t) ? 0.f : __expf(Ft[mt] + Gs[i]); s[i] = (16 * nt + 4 * fq + i > t) ? 0.f : s[i] * wgt; }
            sc[mt][nt] = s; o[mt][nt] = oo * ef[mt]; } }
#pragma unroll
    for (int mt = 0; mt < 2; ++mt) { float rs = 0.f;
#pragma unroll
        for (int nt = 0; nt < 4; ++nt)
#pragma unroll
            for (int i = 0; i < 4; ++i) rs += sc[mt][nt][i];
        rs += __shfl_xor(rs, 16); rs += __shfl_xor(rs, 32); den[mt] += rs; }
#pragma unroll
    for (int k2 = 0; k2 < 2; ++k2) { bf16x8 pf[2];
#pragma unroll
        for (int mt = 0; mt < 2; ++mt) { v4u pw; pw.x = cvtpk(sc[mt][2 * k2][0], sc[mt][2 * k2][1]); pw.y = cvtpk(sc[mt][2 * k2][2], sc[mt][2 * k2][3]); pw.z = cvtpk(sc[mt][2 * k2 + 1][0], sc[mt][2 * k2 + 1][1]); pw.w = cvtpk(sc[mt][2 * k2 + 1][2], sc[mt][2 * k2 + 1][3]); pf[mt] = __builtin_bit_cast(bf16x8, pw); }
#pragma unroll
        for (int nt = 0; nt < 4; ++nt) { const LAS unsigned char* vp = VT + (h * 64 + 16 * nt + fr) * 144 + (32 * k2 + 4 * fq) * 2; const bf16x8 vf = mk8(*(const LAS u64*)vp, *(const LAS u64*)(vp + 32));
#pragma unroll
            for (int mt = 0; mt < 2; ++mt) o[mt][nt] = MFMA16(vf, pf[mt], o[mt][nt]); } }
#pragma unroll
    for (int mt = 0; mt < 2; ++mt) { const float idn = 1.f / fmaxf(fabsf(den[mt]), 1.f); float ss = 0.f;
#pragma unroll
        for (int nt = 0; nt < 4; ++nt) { o[mt][nt] = o[mt][nt] * idn;
#pragma unroll
            for (int i = 0; i < 4; ++i) ss += o[mt][nt][i] * o[mt][nt][i]; }
        ss += __shfl_xor(ss, 16); ss += __shfl_xor(ss, 32); const float r = rsqrtf(ss * (1.f / 64) + EPS); const int tok = tok0 + t0 + 16 * mt + fr;
#pragma unroll
        for (int nt = 0; nt < 4; ++nt) { const int c = h * 64 + 16 * nt + 4 * fq; const f32x4 g = *(const f32x4*)(onorm + c); const v2u gg = *(const v2u*)(P + (size_t)tok * NP + PCO + c);
            const float gx[4] = {__uint_as_float(gg.x << 16), __uint_as_float(gg.x & 0xffff0000u), __uint_as_float(gg.y << 16), __uint_as_float(gg.y & 0xffff0000u)}; float ov[4];
#pragma unroll
            for (int i = 0; i < 4; ++i) ov[i] = o[mt][nt][i] * r * g[i] / (1.f + __expf(-gx[i]));
            v2u pk; pk.x = cvtpk(ov[0], ov[1]); pk.y = cvtpk(ov[2], ov[3]); *(v2u*)(BR + (size_t)tok * 1024 + 512 + c) = pk; } }
    lds_barrier();
}
__global__ void __launch_bounds__(NWAVES * 64, 2) fwd(Args args) {
    extern __shared__ __attribute__((aligned(16))) unsigned char lds[];
    Frame F; F.lds = (LAS unsigned char*)lds; F.tid = threadIdx.x; F.lane = F.tid & 63; F.wave = __builtin_amdgcn_readfirstlane(F.tid >> 6); F.G = gridDim.x;
    F.gw = blockIdx.x * NWAVES + F.wave; F.NGW = F.G * NWAVES;
    volatile LAS unsigned* MISC = (volatile LAS unsigned*)(F.lds + MISC_OFF);
    gu32* ctl = (gu32*)(args.ws + WS_CTL);
    for (int u = F.tid; u < (LDS_BYTES - LDSCTL_OFF) / 4; u += NWAVES * 64) ((LAS unsigned*)(F.lds + LDSCTL_OFF))[u] = 0u;
    __syncthreads();
    XcdBarrier bar = xcd_barrier_post((unsigned*)(ctl + CW_BAR), MISC + 8);
    const int lo = args.ph_lo, hi = args.ph_hi;
#define IN(k) (lo <= (k) && (k) < hi)
#define WSDEF unsigned char* ws = wsp(args); bf16* XN = (bf16*)(ws + WS_XN); bf16* P = (bf16*)(ws + WS_P); bf16* BR = (bf16*)(ws + WS_BR); bf16* MG = (bf16*)(ws + WS_MG); float* Y = (float*)(ws + WS_Y); (void)XN; (void)P; (void)BR; (void)MG; (void)Y;
#define SEAM(k) do { if (IN(k) && IN((k) + 1)) xcd_barrier(bar); } while (0)
    LAS unsigned char* ring = F.lds;
    { constexpr int l = 0;
        constexpr int pb = l * NPH;
        if (IN(pb + 0)) { WSDEF phase_prep(F, args, l); } SEAM(pb + 0);
        if (IN(pb + 1)) { WSDEF
            { pg8::Gemm g{XN, (const bf16*)(ws + WS_WT_IN), M, NP, 1024, 1024, 1024, 0}; pg8::StaticOrder S; S.init(g, F.G, (int)blockIdx.x);
              pg8::EpiStoreBf16 E{P, NP, 1.f}; pg8::gemm_phase<pg8::EpiStoreBf16, pg8::StaticOrder, true, true>(ring, g, S, E); }
            { pg8::Gemm g{(const bf16*)(ws + WS_MEMN), (const bf16*)(ws + WS_WT_XKV), MM, 2048, 1024, 1024, 1024, 0}; pg8::StaticOrder S; S.init(g, F.G, (int)blockIdx.x);
              pg8::EpiStoreBf16 E{(bf16*)(ws + WS_KVX), 2048, 1.f}; pg8::gemm_phase<pg8::EpiStoreBf16, pg8::StaticOrder, true, true>(ring, g, S, E); }
        } SEAM(pb + 1);
        if (IN(pb + 2)) { WSDEF
            { pg8::Gemm g{(const bf16*)(ws + WS_KVX), (const bf16*)(ws + WS_WQ), 256, 1024, 256, 2048, 1024, 0}; pg8::WeOrder S{(int)blockIdx.x};
              pg8::EpiStoreBf16 E{(bf16*)(ws + WS_WET), 1024, 0.0625f}; pg8::gemm_phase<pg8::EpiStoreBf16, pg8::WeOrder, true, true>(ring, g, S, E); }
            { pg8::Gemm g{(const bf16*)(ws + WS_WT_XO), (const bf16*)(ws + WS_KVX), 1024, 256, 256, 1024, 2048, 0}; pg8::VwOrder S{(int)blockIdx.x};
              pg8::EpiStoreBf16 E{(bf16*)(ws + WS_VWT), 1024, 1.f}; pg8::gemm_phase<pg8::EpiStoreBf16, pg8::VwOrder, true, true>(ring, g, S, E); }
            { int tid_ = threadIdx.x; asm volatile("" : "+v"(tid_));
              for (int ch = blockIdx.x; ch < M / 64; ch += F.G) { mla_proj_chunk(F.lds, ws, inp(args, 6) + l * 256, inp(args, 8) + l * 128, (const int*)inp(args, 2), ch, tid_); s5_local_chunk(F.lds, ws, ch, tid_); hg_local_chunk(F.lds, ws, (const float*)(ws + WS_LB) + l * 256, ch, tid_);
                ml_local_chunk(F.lds, ws, inp(args, 12) + l * 1024, inp(args, 13) + l * 256, inp(args, 16) + l * 4, inp(args, 17) + l * 4, ch, tid_); } }
        } SEAM(pb + 2);
        if (IN(pb + 3)) { WSDEF int tid_ = threadIdx.x; asm volatile("" : "+v"(tid_));
            for (int i = blockIdx.x * 512 + tid_; i < 8192; i += F.G * 512) s5_prefix(ws, i);
            for (int i = blockIdx.x * 512 + tid_; i < 131072; i += F.G * 512) { hg_scan(ws, i); ml_scan(ws, i); }
            for (int i = blockIdx.x * 512 + tid_; i < 2048; i += F.G * 512) ml_scan_n(ws, i);
        } SEAM(pb + 3);
        if (IN(pb + 4)) { WSDEF int tid_ = threadIdx.x; asm volatile("" : "+v"(tid_));
            for (int u = blockIdx.x; u < 256; u += F.G) { mla_attn_unit(F.lds, ws, u, tid_); s5_out_chunk(F.lds, ws, inp(args, 26) + l * 256, inp(args, 28) + l * 256, u, tid_);
                hg_out_chunk(F.lds, ws, (const float*)(ws + WS_LB) + l * 256, inp(args, 11) + l * 256, u, tid_);
                ml_out_chunk(F.lds, ws, inp(args, 16) + l * 4, inp(args, 17) + l * 4, inp(args, 18) + l * 256, u, tid_); }
        } SEAM(pb + 4);
        if (IN(pb + 5)) { WSDEF
#pragma unroll 1
            for (int n = 0; n < 4; ++n) { pg8::Gemm g{BR + 256 * n, (const bf16*)(ws + WS_WT_BR) + (size_t)n * 262144, M, 1024, 256, 1024, 256, 0}; pg8::StaticOrder S; S.init(g, F.G, (int)blockIdx.x);
                pg8::EpiGate E{MG, P + PG + 1024 * n, NP, n}; pg8::gemm_phase<pg8::EpiGate, pg8::StaticOrder, true, true>(ring, g, S, E); }
        } SEAM(pb + 5);
        if (IN(pb + 6)) { WSDEF pg8::Gemm g{MG, (const bf16*)(ws + WS_WT_OUT), M, 1024, 1024, 1024, 1024, 0}; pg8::StaticOrder S; S.init(g, F.G, (int)blockIdx.x);
            pg8::EpiStoreF32 E{Y, 1024}; pg8::gemm_phase<pg8::EpiStoreF32, pg8::StaticOrder, true, true>(ring, g, S, E); } SEAM(pb + 6);
        if (IN(pb + 7)) { WSDEF phase_resid(F, args, inp(args, 4) + l * 1024, inp(args, 31) + l * 1024); } SEAM(pb + 7);
        if (IN(pb + 8)) { WSDEF pg8::Gemm g{XN, (const bf16*)(ws + WS_WET), M, 1024, 1024, 1024, 1024, 0}; pg8::BatchedOrder S{F.G, (int)blockIdx.x, 1024, 1024};
            pg8::EpiSoftmax E{(bf16*)(ws + WS_PR), 1024, (PG8_LAS float*)(F.lds + XCH_OFF)}; pg8::gemm_phase<pg8::EpiSoftmax, pg8::BatchedOrder, true, true>(ring, g, S, E); } SEAM(pb + 8);
        if (IN(pb + 9)) { WSDEF pg8::Gemm g{(const bf16*)(ws + WS_PR), (const bf16*)(ws + WS_VWT), M, 1024, 1024, 1024, 1024, 0}; pg8::BatchedOrder S{F.G, (int)blockIdx.x, 1024, 1024};
            pg8::EpiStoreF32 E{Y, 1024}; pg8::gemm_phase<pg8::EpiStoreF32, pg8::BatchedOrder, true, true>(ring, g, S, E); } SEAM(pb + 9);
        if (IN(pb + 10)) { WSDEF phase_resid(F, args, inp(args, 32) + l * 1024, inp(args, 38) + l * 1024); } SEAM(pb + 10);
        if (IN(pb + 11)) { WSDEF pg8::Gemm g{XN, (const bf16*)(ws + WS_WT_FI), M, 2 * DFF, 1024, 1024, 1024, 0}; pg8::StaticOrder S; S.init(g, F.G, (int)blockIdx.x);
            pg8::EpiSwiglu E{(bf16*)(ws + WS_H), DFF}; pg8::gemm_phase<pg8::EpiSwiglu, pg8::StaticOrder, true, true>(ring, g, S, E); } SEAM(pb + 11);
        if (IN(pb + 12)) { WSDEF pg8::Gemm g{(const bf16*)(ws + WS_H), (const bf16*)(ws + WS_WT_FO), M, 1024, DFF, DFF, DFF, 0}; pg8::StaticOrder S; S.init(g, F.G, (int)blockIdx.x);
            pg8::EpiStoreF32 E{Y, 1024}; pg8::gemm_phase<pg8::EpiStoreF32, pg8::StaticOrder, true, true>(ring, g, S, E); } SEAM(pb + 12);
        if (IN(pb + 13)) { WSDEF phase_resid(F, args, inp(args, 39) + l * 1024, l + 1 < DEPTH ? inp(args, 3) + (l + 1) * 1024 : (const float*)nullptr); } SEAM(pb + 13);
    }
    { constexpr int l = 1;
        constexpr int pb = l * NPH;
        if (IN(pb + 0)) { WSDEF phase_prep(F, args, l); } SEAM(pb + 0);
        if (IN(pb + 1)) { WSDEF
            { pg8::Gemm g{XN, (const bf16*)(ws + WS_WT_IN), M, NP, 1024, 1024, 1024, 0}; pg8::StaticOrder S; S.init(g, F.G, (int)blockIdx.x);
              pg8::EpiStoreBf16 E{P, NP, 1.f}; pg8::gemm_phase<pg8::EpiStoreBf16, pg8::StaticOrder, true, true>(ring, g, S, E); }
            { pg8::Gemm g{(const bf16*)(ws + WS_MEMN), (const bf16*)(ws + WS_WT_XKV), MM, 2048, 1024, 1024, 1024, 0}; pg8::StaticOrder S; S.init(g, F.G, (int)blockIdx.x);
              pg8::EpiStoreBf16 E{(bf16*)(ws + WS_KVX), 2048, 1.f}; pg8::gemm_phase<pg8::EpiStoreBf16, pg8::StaticOrder, true, true>(ring, g, S, E); }
        } SEAM(pb + 1);
        if (IN(pb + 2)) { WSDEF
            { pg8::Gemm g{(const bf16*)(ws + WS_KVX), (const bf16*)(ws + WS_WQ), 256, 1024, 256, 2048, 1024, 0}; pg8::WeOrder S{(int)blockIdx.x};
              pg8::EpiStoreBf16 E{(bf16*)(ws + WS_WET), 1024, 0.0625f}; pg8::gemm_phase<pg8::EpiStoreBf16, pg8::WeOrder, true, true>(ring, g, S, E); }
            { pg8::Gemm g{(const bf16*)(ws + WS_WT_XO), (const bf16*)(ws + WS_KVX), 1024, 256, 256, 1024, 2048, 0}; pg8::VwOrder S{(int)blockIdx.x};
              pg8::EpiStoreBf16 E{(bf16*)(ws + WS_VWT), 1024, 1.f}; pg8::gemm_phase<pg8::EpiStoreBf16, pg8::VwOrder, true, true>(ring, g, S, E); }
            { int tid_ = threadIdx.x; asm volatile("" : "+v"(tid_));
              for (int ch = blockIdx.x; ch < M / 64; ch += F.G) { mla_proj_chunk(F.lds, ws, inp(args, 6) + l * 256, inp(args, 8) + l * 128, (const int*)inp(args, 2), ch, tid_); s5_local_chunk(F.lds, ws, ch, tid_); hg_local_chunk(F.lds, ws, (const float*)(ws + WS_LB) + l * 256, ch, tid_);
                ml_local_chunk(F.lds, ws, inp(args, 12) + l * 1024, inp(args, 13) + l * 256, inp(args, 16) + l * 4, inp(args, 17) + l * 4, ch, tid_); } }
        } SEAM(pb + 2);
        if (IN(pb + 3)) { WSDEF int tid_ = threadIdx.x; asm volatile("" : "+v"(tid_));
            for (int i = blockIdx.x * 512 + tid_; i < 8192; i += F.G * 512) s5_prefix(ws, i);
            for (int i = blockIdx.x * 512 + tid_; i < 131072; i += F.G * 512) { hg_scan(ws, i); ml_scan(ws, i); }
            for (int i = blockIdx.x * 512 + tid_; i < 2048; i += F.G * 512) ml_scan_n(ws, i);
        } SEAM(pb + 3);
        if (IN(pb + 4)) { WSDEF int tid_ = threadIdx.x; asm volatile("" : "+v"(tid_));
            for (int u = blockIdx.x; u < 256; u += F.G) { mla_attn_unit(F.lds, ws, u, tid_); s5_out_chunk(F.lds, ws, inp(args, 26) + l * 256, inp(args, 28) + l * 256, u, tid_);
                hg_out_chunk(F.lds, ws, (const float*)(ws + WS_LB) + l * 256, inp(args, 11) + l * 256, u, tid_);
                ml_out_chunk(F.lds, ws, inp(args, 16) + l * 4, inp(args, 17) + l * 4, inp(args, 18) + l * 256, u, tid_); }
        } SEAM(pb + 4);
        if (IN(pb + 5)) { WSDEF
#pragma unroll 1
            for (int n = 0; n < 4; ++n) { pg8::Gemm g{BR + 256 * n, (const bf16*)(ws + WS_WT_BR) + (size_t)n * 262144, M, 1024, 256, 1024, 256, 0}; pg8::StaticOrder S; S.init(g, F.G, (int)blockIdx.x);
                pg8::EpiGate E{MG, P + PG + 1024 * n, NP, n}; pg8::gemm_phase<pg8::EpiGate, pg8::StaticOrder, true, true>(ring, g, S, E); }
        } SEAM(pb + 5);
        if (IN(pb + 6)) { WSDEF pg8::Gemm g{MG, (const bf16*)(ws + WS_WT_OUT), M, 1024, 1024, 1024, 1024, 0}; pg8::StaticOrder S; S.init(g, F.G, (int)blockIdx.x);
            pg8::EpiStoreF32 E{Y, 1024}; pg8::gemm_phase<pg8::EpiStoreF32, pg8::StaticOrder, true, true>(ring, g, S, E); } SEAM(pb + 6);
        if (IN(pb + 7)) { WSDEF phase_resid(F, args, inp(args, 4) + l * 1024, inp(args, 31) + l * 1024); } SEAM(pb + 7);
        if (IN(pb + 8)) { WSDEF pg8::Gemm g{XN, (const bf16*)(ws + WS_WET), M, 1024, 1024, 1024, 1024, 0}; pg8::BatchedOrder S{F.G, (int)blockIdx.x, 1024, 1024};
            pg8::EpiSoftmax E{(bf16*)(ws + WS_PR), 1024, (PG8_LAS float*)(F.lds + XCH_OFF)}; pg8::gemm_phase<pg8::EpiSoftmax, pg8::BatchedOrder, true, true>(ring, g, S, E); } SEAM(pb + 8);
        if (IN(pb + 9)) { WSDEF pg8::Gemm g{(const bf16*)(ws + WS_PR), (const bf16*)(ws + WS_VWT), M, 1024, 1024, 1024, 1024, 0}; pg8::BatchedOrder S{F.G, (int)blockIdx.x, 1024, 1024};
            pg8::EpiStoreF32 E{Y, 1024}; pg8::gemm_phase<pg8::EpiStoreF32, pg8::BatchedOrder, true, true>(ring, g, S, E); } SEAM(pb + 9);
        if (IN(pb + 10)) { WSDEF phase_resid(F, args, inp(args, 32) + l * 1024, inp(args, 38) + l * 1024); } SEAM(pb + 10);
        if (IN(pb + 11)) { WSDEF pg8::Gemm g{XN, (const bf16*)(ws + WS_WT_FI), M, 2 * DFF, 1024, 1024, 1024, 0}; pg8::StaticOrder S; S.init(g, F.G, (int)blockIdx.x);
            pg8::EpiSwiglu E{(bf16*)(ws + WS_H), DFF}; pg8::gemm_phase<pg8::EpiSwiglu, pg8::StaticOrder, true, true>(ring, g, S, E); } SEAM(pb + 11);
        if (IN(pb + 12)) { WSDEF pg8::Gemm g{(const bf16*)(ws + WS_H), (const bf16*)(ws + WS_WT_FO), M, 1024, DFF, DFF, DFF, 0}; pg8::StaticOrder S; S.init(g, F.G, (int)blockIdx.x);
            pg8::EpiStoreF32 E{Y, 1024}; pg8::gemm_phase<pg8::EpiStoreF32, pg8::StaticOrder, true, true>(ring, g, S, E); } SEAM(pb + 12);
        if (IN(pb + 13)) { WSDEF phase_resid(F, args, inp(args, 39) + l * 1024, l + 1 < DEPTH ? inp(args, 3) + (l + 1) * 1024 : (const float*)nullptr); } SEAM(pb + 13);
    }
    { constexpr int l = 2;
        constexpr int pb = l * NPH;
        if (IN(pb + 0)) { WSDEF phase_prep(F, args, l); } SEAM(pb + 0);
        if (IN(pb + 1)) { WSDEF
            { pg8::Gemm g{XN, (const bf16*)(ws + WS_WT_IN), M, NP, 1024, 1024, 1024, 0}; pg8::StaticOrder S; S.init(g, F.G, (int)blockIdx.x);
              pg8::EpiStoreBf16 E{P, NP, 1.f}; pg8::gemm_phase<pg8::EpiStoreBf16, pg8::StaticOrder, true, true>(ring, g, S, E); }
            { pg8::Gemm g{(const bf16*)(ws + WS_MEMN), (const bf16*)(ws + WS_WT_XKV), MM, 2048, 1024, 1024, 1024, 0}; pg8::StaticOrder S; S.init(g, F.G, (int)blockIdx.x);
              pg8::EpiStoreBf16 E{(bf16*)(ws + WS_KVX), 2048, 1.f}; pg8::gemm_phase<pg8::EpiStoreBf16, pg8::StaticOrder, true, true>(ring, g, S, E); }
        } SEAM(pb + 1);
        if (IN(pb + 2)) { WSDEF
            { pg8::Gemm g{(const bf16*)(ws + WS_KVX), (const bf16*)(ws + WS_WQ), 256, 1024, 256, 2048, 1024, 0}; pg8::WeOrder S{(int)blockIdx.x};
              pg8::EpiStoreBf16 E{(bf16*)(ws + WS_WET), 1024, 0.0625f}; pg8::gemm_phase<pg8::EpiStoreBf16, pg8::WeOrder, true, true>(ring, g, S, E); }
            { pg8::Gemm g{(const bf16*)(ws + WS_WT_XO), (const bf16*)(ws + WS_KVX), 1024, 256, 256, 1024, 2048, 0}; pg8::VwOrder S{(int)blockIdx.x};
              pg8::EpiStoreBf16 E{(bf16*)(ws + WS_VWT), 1024, 1.f}; pg8::gemm_phase<pg8::EpiStoreBf16, pg8::VwOrder, true, true>(ring, g, S, E); }
            { int tid_ = threadIdx.x; asm volatile("" : "+v"(tid_));
              for (int ch = blockIdx.x; ch < M / 64; ch += F.G) { mla_proj_chunk(F.lds, ws, inp(args, 6) + l * 256, inp(args, 8) + l * 128, (const int*)inp(args, 2), ch, tid_); s5_local_chunk(F.lds, ws, ch, tid_); hg_local_chunk(F.lds, ws, (const float*)(ws + WS_LB) + l * 256, ch, tid_);
                ml_local_chunk(F.lds, ws, inp(args, 12) + l * 1024, inp(args, 13) + l * 256, inp(args, 16) + l * 4, inp(args, 17) + l * 4, ch, tid_); } }
        } SEAM(pb + 2);
        if (IN(pb + 3)) { WSDEF int tid_ = threadIdx.x; asm volatile("" : "+v"(tid_));
            for (int i = blockIdx.x * 512 + tid_; i < 8192; i += F.G * 512) s5_prefix(ws, i);
            for (int i = blockIdx.x * 512 + tid_; i < 131072; i += F.G * 512) { hg_scan(ws, i); ml_scan(ws, i); }
            for (int i = blockIdx.x * 512 + tid_; i < 2048; i += F.G * 512) ml_scan_n(ws, i);
        } SEAM(pb + 3);
        if (IN(pb + 4)) { WSDEF int tid_ = threadIdx.x; asm volatile("" : "+v"(tid_));
            for (int u = blockIdx.x; u < 256; u += F.G) { mla_attn_unit(F.lds, ws, u, tid_); s5_out_chunk(F.lds, ws, inp(args, 26) + l * 256, inp(args, 28) + l * 256, u, tid_);
                hg_out_chunk(F.lds, ws, (const float*)(ws + WS_LB) + l * 256, inp(args, 11) + l * 256, u, tid_);
                ml_out_chunk(F.lds, ws, inp(args, 16) + l * 4, inp(args, 17) + l * 4, inp(args, 18) + l * 256, u, tid_); }
        } SEAM(pb + 4);
        if (IN(pb + 5)) { WSDEF
#pragma unroll 1
            for (int n = 0; n < 4; ++n) { pg8::Gemm g{BR + 256 * n, (const bf16*)(ws + WS_WT_BR) + (size_t)n * 262144, M, 1024, 256, 1024, 256, 0}; pg8::StaticOrder S; S.init(g, F.G, (int)blockIdx.x);
                pg8::EpiGate E{MG, P + PG + 1024 * n, NP, n}; pg8::gemm_phase<pg8::EpiGate, pg8::StaticOrder, true, true>(ring, g, S, E); }
        } SEAM(pb + 5);
        if (IN(pb + 6)) { WSDEF pg8::Gemm g{MG, (const bf16*)(ws + WS_WT_OUT), M, 1024, 1024, 1024, 1024, 0}; pg8::StaticOrder S; S.init(g, F.G, (int)blockIdx.x);
            pg8::EpiStoreF32 E{Y, 1024}; pg8::gemm_phase<pg8::EpiStoreF32, pg8::StaticOrder, true, true>(ring, g, S, E); } SEAM(pb + 6);
        if (IN(pb + 7)) { WSDEF phase_resid(F, args, inp(args, 4) + l * 1024, inp(args, 31) + l * 1024); } SEAM(pb + 7);
        if (IN(pb + 8)) { WSDEF pg8::Gemm g{XN, (const bf16*)(ws + WS_WET), M, 1024, 1024, 1024, 1024, 0}; pg8::BatchedOrder S{F.G, (int)blockIdx.x, 1024, 1024};
            pg8::EpiSoftmax E{(bf16*)(ws + WS_PR), 1024, (PG8_LAS float*)(F.lds + XCH_OFF)}; pg8::gemm_phase<pg8::EpiSoftmax, pg8::BatchedOrder, true, true>(ring, g, S, E); } SEAM(pb + 8);
        if (IN(pb + 9)) { WSDEF pg8::Gemm g{(const bf16*)(ws + WS_PR), (const bf16*)(ws + WS_VWT), M, 1024, 1024, 1024, 1024, 0}; pg8::BatchedOrder S{F.G, (int)blockIdx.x, 1024, 1024};
            pg8::EpiStoreF32 E{Y, 1024}; pg8::gemm_phase<pg8::EpiStoreF32, pg8::BatchedOrder, true, true>(ring, g, S, E); } SEAM(pb + 9);
        if (IN(pb + 10)) { WSDEF phase_resid(F, args, inp(args, 32) + l * 1024, inp(args, 38) + l * 1024); } SEAM(pb + 10);
        if (IN(pb + 11)) { WSDEF pg8::Gemm g{XN, (const bf16*)(ws + WS_WT_FI), M, 2 * DFF, 1024, 1024, 1024, 0}; pg8::StaticOrder S; S.init(g, F.G, (int)blockIdx.x);
            pg8::EpiSwiglu E{(bf16*)(ws + WS_H), DFF}; pg8::gemm_phase<pg8::EpiSwiglu, pg8::StaticOrder, true, true>(ring, g, S, E); } SEAM(pb + 11);
        if (IN(pb + 12)) { WSDEF pg8::Gemm g{(const bf16*)(ws + WS_H), (const bf16*)(ws + WS_WT_FO), M, 1024, DFF, DFF, DFF, 0}; pg8::StaticOrder S; S.init(g, F.G, (int)blockIdx.x);
            pg8::EpiStoreF32 E{Y, 1024}; pg8::gemm_phase<pg8::EpiStoreF32, pg8::StaticOrder, true, true>(ring, g, S, E); } SEAM(pb + 12);
        if (IN(pb + 13)) { WSDEF phase_resid(F, args, inp(args, 39) + l * 1024, l + 1 < DEPTH ? inp(args, 3) + (l + 1) * 1024 : (const float*)nullptr); } SEAM(pb + 13);
    }
    { constexpr int l = 3;
        constexpr int pb = l * NPH;
        if (IN(pb + 0)) { WSDEF phase_prep(F, args, l); } SEAM(pb + 0);
        if (IN(pb + 1)) { WSDEF
            { pg8::Gemm g{XN, (const bf16*)(ws + WS_WT_IN), M, NP, 1024, 1024, 1024, 0}; pg8::StaticOrder S; S.init(g, F.G, (int)blockIdx.x);
              pg8::EpiStoreBf16 E{P, NP, 1.f}; pg8::gemm_phase<pg8::EpiStoreBf16, pg8::StaticOrder, true, true>(ring, g, S, E); }
            { pg8::Gemm g{(const bf16*)(ws + WS_MEMN), (const bf16*)(ws + WS_WT_XKV), MM, 2048, 1024, 1024, 1024, 0}; pg8::StaticOrder S; S.init(g, F.G, (int)blockIdx.x);
              pg8::EpiStoreBf16 E{(bf16*)(ws + WS_KVX), 2048, 1.f}; pg8::gemm_phase<pg8::EpiStoreBf16, pg8::StaticOrder, true, true>(ring, g, S, E); }
        } SEAM(pb + 1);
        if (IN(pb + 2)) { WSDEF
            { pg8::Gemm g{(const bf16*)(ws + WS_KVX), (const bf16*)(ws + WS_WQ), 256, 1024, 256, 2048, 1024, 0}; pg8::WeOrder S{(int)blockIdx.x};
              pg8::EpiStoreBf16 E{(bf16*)(ws + WS_WET), 1024, 0.0625f}; pg8::gemm_phase<pg8::EpiStoreBf16, pg8::WeOrder, true, true>(ring, g, S, E); }
            { pg8::Gemm g{(const bf16*)(ws + WS_WT_XO), (const bf16*)(ws + WS_KVX), 1024, 256, 256, 1024, 2048, 0}; pg8::VwOrder S{(int)blockIdx.x};
              pg8::EpiStoreBf16 E{(bf16*)(ws + WS_VWT), 1024, 1.f}; pg8::gemm_phase<pg8::EpiStoreBf16, pg8::VwOrder, true, true>(ring, g, S, E); }
            { int tid_ = threadIdx.x; asm volatile("" : "+v"(tid_));
              for (int ch = blockIdx.x; ch < M / 64; ch += F.G) { mla_proj_chunk(F.lds, ws, inp(args, 6) + l * 256, inp(args, 8) + l * 128, (const int*)inp(args, 2), ch, tid_); s5_local_chunk(F.lds, ws, ch, tid_); hg_local_chunk(F.lds, ws, (const float*)(ws + WS_LB) + l * 256, ch, tid_);
                ml_local_chunk(F.lds, ws, inp(args, 12) + l * 1024, inp(args, 13) + l * 256, inp(args, 16) + l * 4, inp(args, 17) + l * 4, ch, tid_); } }
        } SEAM(pb + 2);
        if (IN(pb + 3)) { WSDEF int tid_ = threadIdx.x; asm volatile("" : "+v"(tid_));
            for (int i = blockIdx.x * 512 + tid_; i < 8192; i += F.G * 512) s5_prefix(ws, i);
            for (int i = blockIdx.x * 512 + tid_; i < 131072; i += F.G * 512) { hg_scan(ws, i); ml_scan(ws, i); }
            for (int i = blockIdx.x * 512 + tid_; i < 2048; i += F.G * 512) ml_scan_n(ws, i);
        } SEAM(pb + 3);
        if (IN(pb + 4)) { WSDEF int tid_ = threadIdx.x; asm volatile("" : "+v"(tid_));
            for (int u = blockIdx.x; u < 256; u += F.G) { mla_attn_unit(F.lds, ws, u, tid_); s5_out_chunk(F.lds, ws, inp(args, 26) + l * 256, inp(args, 28) + l * 256, u, tid_);
                hg_out_chunk(F.lds, ws, (const float*)(ws + WS_LB) + l * 256, inp(args, 11) + l * 256, u, tid_);
                ml_out_chunk(F.lds, ws, inp(args, 16) + l * 4, inp(args, 17) + l * 4, inp(args, 18) + l * 256, u, tid_); }
        } SEAM(pb + 4);
        if (IN(pb + 5)) { WSDEF
#pragma unroll 1
            for (int n = 0; n < 4; ++n) { pg8::Gemm g{BR + 256 * n, (const bf16*)(ws + WS_WT_BR) + (size_t)n * 262144, M, 1024, 256, 1024, 256, 0}; pg8::StaticOrder S; S.init(g, F.G, (int)blockIdx.x);
                pg8::EpiGate E{MG, P + PG + 1024 * n, NP, n}; pg8::gemm_phase<pg8::EpiGate, pg8::StaticOrder, true, true>(ring, g, S, E); }
        } SEAM(pb + 5);
        if (IN(pb + 6)) { WSDEF pg8::Gemm g{MG, (const bf16*)(ws + WS_WT_OUT), M, 1024, 1024, 1024, 1024, 0}; pg8::StaticOrder S; S.init(g, F.G, (int)blockIdx.x);
            pg8::EpiStoreF32 E{Y, 1024}; pg8::gemm_phase<pg8::EpiStoreF32, pg8::StaticOrder, true, true>(ring, g, S, E); } SEAM(pb + 6);
        if (IN(pb + 7)) { WSDEF phase_resid(F, args, inp(args, 4) + l * 1024, inp(args, 31) + l * 1024); } SEAM(pb + 7);
        if (IN(pb + 8)) { WSDEF pg8::Gemm g{XN, (const bf16*)(ws + WS_WET), M, 1024, 1024, 1024, 1024, 0}; pg8::BatchedOrder S{F.G, (int)blockIdx.x, 1024, 1024};
            pg8::EpiSoftmax E{(bf16*)(ws + WS_PR), 1024, (PG8_LAS float*)(F.lds + XCH_OFF)}; pg8::gemm_phase<pg8::EpiSoftmax, pg8::BatchedOrder, true, true>(ring, g, S, E); } SEAM(pb + 8);
        if (IN(pb + 9)) { WSDEF pg8::Gemm g{(const bf16*)(ws + WS_PR), (const bf16*)(ws + WS_VWT), M, 1024, 1024, 1024, 1024, 0}; pg8::BatchedOrder S{F.G, (int)blockIdx.x, 1024, 1024};
            pg8::EpiStoreF32 E{Y, 1024}; pg8::gemm_phase<pg8::EpiStoreF32, pg8::BatchedOrder, true, true>(ring, g, S, E); } SEAM(pb + 9);
        if (IN(pb + 10)) { WSDEF phase_resid(F, args, inp(args, 32) + l * 1024, inp(args, 38) + l * 1024); } SEAM(pb + 10);
        if (IN(pb + 11)) { WSDEF pg8::Gemm g{XN, (const bf16*)(ws + WS_WT_FI), M, 2 * DFF, 1024, 1024, 1024, 0}; pg8::StaticOrder S; S.init(g, F.G, (int)blockIdx.x);
            pg8::EpiSwiglu E{(bf16*)(ws + WS_H), DFF}; pg8::gemm_phase<pg8::EpiSwiglu, pg8::StaticOrder, true, true>(ring, g, S, E); } SEAM(pb + 11);
        if (IN(pb + 12)) { WSDEF pg8::Gemm g{(const bf16*)(ws + WS_H), (const bf16*)(ws + WS_WT_FO), M, 1024, DFF, DFF, DFF, 0}; pg8::StaticOrder S; S.init(g, F.G, (int)blockIdx.x);
            pg8::EpiStoreF32 E{Y, 1024}; pg8::gemm_phase<pg8::EpiStoreF32, pg8::StaticOrder, true, true>(ring, g, S, E); } SEAM(pb + 12);
        if (IN(pb + 13)) { WSDEF phase_resid(F, args, inp(args, 39) + l * 1024, l + 1 < DEPTH ? inp(args, 3) + (l + 1) * 1024 : (const float*)nullptr); } SEAM(pb + 13);
    }

#undef IN
#undef SEAM
}
static void launch_fwd(hipStream_t st, Args a, int lo, int hi, int grid) { a.ph_lo = lo; a.ph_hi = hi; (void)hipMemsetAsync((char*)a.ws + WS_CTL, 0, CTL_ZERO_BYTES, st);     hipLaunchKernelGGL(fwd, dim3(grid), dim3(NWAVES * 64), LDS_BYTES, st, a); }
extern "C" void kernel_launch(void* const* d_in, const int* in_sizes, int n_in, void* d_out, int out_size, void* d_ws, size_t ws_size, hipStream_t stream) {
    static int grid = 0;
    if (grid == 0) {
        if (n_in != 42 || out_size != M * D || ws_size < WS_END) { fprintf(stderr, "kernel_launch: unexpected shapes (n_in %d out %d ws %zu)\n", n_in, out_size, ws_size); grid = -1; return; }
        int dev = 0, cus = 0;
        if (hipGetDevice(&dev) != hipSuccess || hipDeviceGetAttribute(&cus, hipDeviceAttributeMultiprocessorCount, dev) != hipSuccess) { grid = -1; return; }
        if (hipFuncSetAttribute((const void*)fwd, hipFuncAttributeMaxDynamicSharedMemorySize, LDS_BYTES) != hipSuccess) { grid = -1; return; }
        int per_cu = 0; (void)hipOccupancyMaxActiveBlocksPerMultiprocessor(&per_cu, (const void*)fwd, NWAVES * 64, LDS_BYTES); (void)hipGetLastError();
        grid = (per_cu >= 1) ? cus : -1;
    }
    if (grid < 0) return;
    Args a{}; for (int i = 0; i < 42; ++i) a.in[i] = (const float*)d_in[i]; a.out = (float*)d_out; a.ws = (unsigned char*)d_ws;
#if 0
    for (int p = 0; p < N_PHASES; ++p) launch_fwd(stream, a, p, p + 1, grid);
#else
    launch_fwd(stream, a, 0, N_PHASES, grid);
#endif
}
```
